# Optimizing an MI355X kernel written in HIP

```python
import math
import jax
import jax.numpy as jnp
from jax import lax
import numpy as np

D_MODEL = 1024
BATCH = 4
SEQ = 4096
DEPTH = 2
DEC_BATCH = 32
DEC_SEQ = 64
PAST_LEN = 4096

CHUNK = 64
Q_BLOCK = 128
SB_HEADS = 4
SB_HD = 64
SB_W = SB_HEADS * SB_HD
GLA_HEADS = 4
GLA_DK = 32
GLA_DV = 64
GLA_QK_W = GLA_HEADS * GLA_DK
GLA_W = GLA_HEADS * GLA_DV
GLA_GATE_RANK = 16
GLA_TAU = 16.0
GLA_BLOCK = 16
MLA_HEADS = 8
MLA_Q_LORA = 256
MLA_KV_LORA = 128
MLA_NOPE = 64
MLA_ROPE = 32
MLA_V = 64
MLA_W = MLA_HEADS * MLA_V
ROPE_THETA = 10000.0
MIX_W = SB_W + GLA_W + MLA_W
N_IN = 3 * SB_W + 2 * GLA_QK_W + 2 * GLA_W + GLA_GATE_RANK + MLA_Q_LORA + MLA_KV_LORA + MLA_ROPE
MEM_LEN = 256
MEM_HEADS = 4
MEM_HD = 128
MEM_W = MEM_HEADS * MEM_HD
D_FF = -(-8 * D_MODEL // (3 * 256)) * 256
NORM_EPS = 1e-6

kernel_name = 'hybrid_sb_gla_mla_stream_step'


def rmsnorm(x, g):
    xf = x.astype(jnp.float32)
    y = xf * lax.rsqrt(jnp.mean(xf * xf, axis=-1, keepdims=True) + NORM_EPS)
    return (y * g.astype(jnp.float32)).astype(x.dtype)


def rope(x, pos):
    half = x.shape[-1] // 2
    freqs = ROPE_THETA ** (-jnp.arange(half, dtype=jnp.float32) / half)
    ang = pos.astype(jnp.float32)[:, None] * freqs[None, :]
    shape = (pos.shape[0],) + (1,) * (x.ndim - 3) + (half,)
    cos = jnp.cos(ang).reshape(shape)
    sin = jnp.sin(ang).reshape(shape)
    xf = x.astype(jnp.float32)
    x1, x2 = xf[..., :half], xf[..., half:]
    return jnp.concatenate([x1 * cos - x2 * sin, x1 * sin + x2 * cos], axis=-1).astype(x.dtype)


def to_blocks(a, qb):
    B, T = a.shape[0], a.shape[1]
    return jnp.swapaxes(a.reshape((B, T // qb, qb) + a.shape[2:]), 0, 1)


def from_blocks(a):
    nb, B, qb = a.shape[:3]
    return jnp.swapaxes(a, 0, 1).reshape((B, nb * qb) + a.shape[3:])


def stick_breaking_attention(q, k, v, q_pos, k_pos):
    T = q.shape[1]
    qb = Q_BLOCK if T % Q_BLOCK == 0 else T
    scale = 1.0 / math.sqrt(q.shape[-1])

    def block(args):
        qblk, pblk = args
        z = jnp.einsum('bqhd,bkhd->bhqk', qblk, k).astype(jnp.float32) * scale
        visible = k_pos[None, :] < pblk[:, None]
        log_keep = jnp.where(visible, jax.nn.log_sigmoid(-z), 0.0)
        later = lax.cumsum(log_keep, axis=3, reverse=True) - log_keep
        wts = jnp.where(visible, jnp.exp(jax.nn.log_sigmoid(z) + later), 0.0)
        return jnp.einsum('bhqk,bkhd->bqhd', wts.astype(v.dtype), v)

    out = lax.map(block, (to_blocks(q, qb), q_pos.reshape(-1, qb)))
    return from_blocks(out)


def gla_recurrence(q, k, v, log_a, s0):
    T, dk = q.shape[1], q.shape[-1]
    pad = (-T) % GLA_BLOCK
    scale = dk ** -0.5

    def prep(a):
        a = jnp.pad(a.astype(jnp.float32), ((0, 0), (0, pad), (0, 0), (0, 0)))
        return to_blocks(a, GLA_BLOCK)

    tril = jnp.tril(jnp.ones((GLA_BLOCK, GLA_BLOCK), dtype=bool))

    def step(S, blk):
        qc, kc, vc, ac = blk
        b = jnp.cumsum(ac, axis=1)
        qt = qc * jnp.exp(b) * scale
        kt = kc * jnp.exp(-b)
        att = jnp.where(tril, jnp.einsum('bchk,bshk->bhcs', qt, kt), 0.0)
        o = jnp.einsum('bchk,bhkv->bchv', qt, S) + jnp.einsum('bhcs,bshv->bchv', att, vc)
        b_last = b[:, -1]
        kd = kc * jnp.exp(b_last[:, None] - b)
        S = jnp.exp(b_last)[..., None] * S + jnp.einsum('bchk,bchv->bhkv', kd, vc)
        return S, o

    S, o = lax.scan(step, s0.astype(jnp.float32), (prep(q), prep(k), prep(v), prep(log_a)))
    o = from_blocks(o)[:, :T]
    return o.astype(v.dtype), S.astype(s0.dtype)


def chunk_causal_attention(q_nope, q_rope, k_nope, k_rope, v, q_pos, k_pos):
    T = q_nope.shape[1]
    qb = Q_BLOCK if T % Q_BLOCK == 0 else T
    scale = (q_nope.shape[-1] + q_rope.shape[-1]) ** -0.5
    k_chunk = k_pos // CHUNK

    def block(args):
        qn, qr, pb = args
        s = (jnp.einsum('bqhd,bkhd->bhqk', qn, k_nope)
             + jnp.einsum('bqhr,bkr->bhqk', qr, k_rope)).astype(jnp.float32) * scale
        visible = k_chunk[None, :] <= (pb // CHUNK)[:, None]
        s = jnp.where(visible, s, -1e30)
        p = jax.nn.softmax(s, axis=-1).astype(v.dtype)
        return jnp.einsum('bhqk,bkhd->bqhd', p, v)

    out = lax.map(block, (to_blocks(q_nope, qb), to_blocks(q_rope, qb), q_pos.reshape(-1, qb)))
    return from_blocks(out)


def mla_attention(cq, ckv, kr_raw, lat_past, kr_past, q_pos, k_pos, w):
    B, T = cq.shape[:2]
    q = (rmsnorm(cq, w['g_cq']) @ w['w_uq']).reshape(B, T, MLA_HEADS, MLA_NOPE + MLA_ROPE)
    q_nope = rmsnorm(q[..., :MLA_NOPE], w['g_qn'])
    q_rope = rope(rmsnorm(q[..., MLA_NOPE:], w['g_qr']), q_pos)
    lat = rmsnorm(ckv, w['g_ckv'])
    kr = rope(rmsnorm(kr_raw, w['g_kr']), q_pos)
    lat_all = jnp.concatenate([lat_past, lat], axis=1)
    kr_all = jnp.concatenate([kr_past, kr], axis=1)
    L = lat_all.shape[1]
    kv = (lat_all @ w['w_ukv']).reshape(B, L, MLA_HEADS, MLA_NOPE + MLA_V)
    k_nope = rmsnorm(kv[..., :MLA_NOPE], w['g_kn'])
    v = kv[..., MLA_NOPE:]
    out = chunk_causal_attention(q_nope, q_rope, k_nope, kr_all, v, q_pos, k_pos)
    return out, lat, kr


def memory_kv(mem, w):
    B, M, _ = mem.shape
    h = rmsnorm(mem, w['g_mem_norm'])
    k = rmsnorm((h @ w['w_ck']).reshape(B, M, MEM_HEADS, MEM_HD), w['g_ckn'])
    v = (h @ w['w_cv']).reshape(B, M, MEM_HEADS, MEM_HD)
    return k, v


def memory_cross_attention(h, mem_k, mem_v, w):
    B, T, _ = h.shape
    q = rmsnorm((h @ w['w_cq']).reshape(B, T, MEM_HEADS, MEM_HD), w['g_cqn'])
    s = jnp.einsum('bqhd,bkhd->bhqk', q, mem_k).astype(jnp.float32) * (MEM_HD ** -0.5)
    p = jax.nn.softmax(s, axis=-1).astype(mem_v.dtype)
    o = jnp.einsum('bhqk,bkhd->bqhd', p, mem_v).reshape(B, T, MEM_W)
    return o @ w['w_co']


def trunk_layer(x, sb_k_past, sb_v_past, gla_s0, lat_past, kr_past, mem_k, mem_v, w):
    B, T, _ = x.shape
    P = sb_k_past.shape[1]
    q_pos = P + jnp.arange(T, dtype=jnp.int32)
    k_pos = jnp.arange(P + T, dtype=jnp.int32)
    h = rmsnorm(x, w['g_mix_norm'])
    proj = h @ w['w_in']
    sizes = (SB_W, SB_W, SB_W, GLA_QK_W, GLA_QK_W, GLA_W, GLA_GATE_RANK, GLA_W,
             MLA_Q_LORA, MLA_KV_LORA, MLA_ROPE)
    offsets = []
    acc = 0
    for s in sizes[:-1]:
        acc += s
        offsets.append(acc)
    qa, ka, va, qg, kg, vg, ag, rg, cq, ckv, kr_raw = jnp.split(proj, offsets, axis=-1)
    qa = qa.reshape(B, T, SB_HEADS, SB_HD)
    ka = ka.reshape(B, T, SB_HEADS, SB_HD)
    va = va.reshape(B, T, SB_HEADS, SB_HD)
    o_a = stick_breaking_attention(qa, jnp.concatenate([sb_k_past, ka], axis=1),
                                   jnp.concatenate([sb_v_past, va], axis=1), q_pos, k_pos)
    o_a = rmsnorm(o_a, w['g_sb_out']).reshape(B, T, SB_W)
    log_a = jax.nn.log_sigmoid((ag @ w['w_gla_gate'] + w['b_gla_gate']).astype(jnp.float32)) / GLA_TAU
    o_b, gla_s = gla_recurrence(qg.reshape(B, T, GLA_HEADS, GLA_DK), kg.reshape(B, T, GLA_HEADS, GLA_DK),
                                vg.reshape(B, T, GLA_HEADS, GLA_DV),
                                log_a.reshape(B, T, GLA_HEADS, GLA_DK), gla_s0)
    o_b = rmsnorm(o_b, w['g_gla_out']).reshape(B, T, GLA_W) * jax.nn.silu(rg)
    o_c, lat, kr = mla_attention(cq, ckv, kr_raw, lat_past, kr_past, q_pos, k_pos, w)
    o_c = rmsnorm(o_c, w['g_mla_out']).reshape(B, T, MLA_W)
    x = x + jnp.concatenate([o_a, o_b, o_c], axis=-1) @ w['w_out']
    x = x + memory_cross_attention(rmsnorm(x, w['g_cross_norm']), mem_k, mem_v, w)
    h = rmsnorm(x, w['g_ffn_norm'])
    x = x + (jax.nn.silu(h @ w['w_gate']) * (h @ w['w_up'])) @ w['w_down']
    return x, ka, va, gla_s, lat, kr


def setup_inputs(seed: int = 0) -> dict:
    key = jax.random.key(seed)
    ks = iter(jax.random.split(key, 64))
    f32 = jnp.float32

    def nrm(shape, scale=1.0):
        return jax.random.normal(next(ks), shape, f32) * scale

    def gain(n):
        return 1.0 + 0.02 * jax.random.normal(next(ks), (DEPTH, n), f32)

    return {
        'x_prompt': nrm((BATCH, SEQ, D_MODEL)),
        'x_sample': nrm((DEC_BATCH, DEC_SEQ, D_MODEL)),
        'mem_prompt': nrm((BATCH, MEM_LEN, D_MODEL)),
        'cache_sb_k': nrm((DEPTH, DEC_BATCH, PAST_LEN, SB_HEADS, SB_HD)),
        'cache_sb_v': nrm((DEPTH, DEC_BATCH, PAST_LEN, SB_HEADS, SB_HD)),
        'state_gla': nrm((DEPTH, DEC_BATCH, GLA_HEADS, GLA_DK, GLA_DV), 0.5),
        'cache_mla_latent': nrm((DEPTH, DEC_BATCH, PAST_LEN, MLA_KV_LORA)),
        'cache_mla_krope': nrm((DEPTH, DEC_BATCH, PAST_LEN, MLA_ROPE)),
        'cache_mem_k': nrm((DEPTH, DEC_BATCH, MEM_LEN, MEM_HEADS, MEM_HD)),
        'cache_mem_v': nrm((DEPTH, DEC_BATCH, MEM_LEN, MEM_HEADS, MEM_HD)),
        'g_mix_norm': gain(D_MODEL),
        'w_in': nrm((DEPTH, D_MODEL, N_IN), D_MODEL ** -0.5),
        'w_gla_gate': nrm((DEPTH, GLA_GATE_RANK, GLA_QK_W), GLA_GATE_RANK ** -0.5),
        'b_gla_gate': nrm((DEPTH, GLA_QK_W), 0.1),
        'g_gla_out': gain(GLA_DV),
        'g_sb_out': gain(SB_HD),
        'g_cq': gain(MLA_Q_LORA),
        'w_uq': nrm((DEPTH, MLA_Q_LORA, MLA_HEADS * (MLA_NOPE + MLA_ROPE)), MLA_Q_LORA ** -0.5),
        'g_qn': gain(MLA_NOPE),
        'g_qr': gain(MLA_ROPE),
        'g_kr': gain(MLA_ROPE),
        'g_ckv': gain(MLA_KV_LORA),
        'w_ukv': nrm((DEPTH, MLA_KV_LORA, MLA_HEADS * (MLA_NOPE + MLA_V)), MLA_KV_LORA ** -0.5),
        'g_kn': gain(MLA_NOPE),
        'g_mla_out': gain(MLA_V),
        'w_out': nrm((DEPTH, MIX_W, D_MODEL), MIX_W ** -0.5),
        'g_cross_norm': gain(D_MODEL),
        'g_mem_norm': gain(D_MODEL),
        'w_cq': nrm((DEPTH, D_MODEL, MEM_W), D_MODEL ** -0.5),
        'w_ck': nrm((DEPTH, D_MODEL, MEM_W), D_MODEL ** -0.5),
        'w_cv': nrm((DEPTH, D_MODEL, MEM_W), D_MODEL ** -0.5),
        'g_cqn': gain(MEM_HD),
        'g_ckn': gain(MEM_HD),
        'w_co': nrm((DEPTH, MEM_W, D_MODEL), MEM_W ** -0.5),
        'g_ffn_norm': gain(D_MODEL),
        'w_gate': nrm((DEPTH, D_MODEL, D_FF), D_MODEL ** -0.5),
        'w_up': nrm((DEPTH, D_MODEL, D_FF), D_MODEL ** -0.5),
        'w_down': nrm((DEPTH, D_FF, D_MODEL), D_FF ** -0.5),
    }


def reference(x_prompt, x_sample, mem_prompt, cache_sb_k, cache_sb_v, state_gla, cache_mla_latent,
              cache_mla_krope, cache_mem_k, cache_mem_v, g_mix_norm, w_in, w_gla_gate, b_gla_gate,
              g_gla_out, g_sb_out, g_cq, w_uq, g_qn, g_qr, g_kr, g_ckv, w_ukv, g_kn, g_mla_out, w_out,
              g_cross_norm, g_mem_norm, w_cq, w_ck, w_cv, g_cqn, g_ckn, w_co, g_ffn_norm, w_gate,
              w_up, w_down):
    dt = x_prompt.dtype
    B = x_prompt.shape[0]
    empty_kv = jnp.zeros((B, 0, SB_HEADS, SB_HD), dt)
    empty_lat = jnp.zeros((B, 0, MLA_KV_LORA), dt)
    empty_kr = jnp.zeros((B, 0, MLA_ROPE), dt)
    zero_state = jnp.zeros((B, GLA_HEADS, GLA_DK, GLA_DV), dt)
    xp, xs = x_prompt, x_sample
    p_k, p_v, p_s, p_lat, p_kr, p_mk, p_mv = [], [], [], [], [], [], []
    s_k, s_v, s_s, s_lat, s_kr = [], [], [], [], []
    for l in range(DEPTH):
        w = {
            'g_mix_norm': g_mix_norm[l], 'w_in': w_in[l], 'w_gla_gate': w_gla_gate[l],
            'b_gla_gate': b_gla_gate[l], 'g_gla_out': g_gla_out[l], 'g_sb_out': g_sb_out[l],
            'g_cq': g_cq[l], 'w_uq': w_uq[l], 'g_qn': g_qn[l], 'g_qr': g_qr[l], 'g_kr': g_kr[l],
            'g_ckv': g_ckv[l], 'w_ukv': w_ukv[l], 'g_kn': g_kn[l], 'g_mla_out': g_mla_out[l],
            'w_out': w_out[l], 'g_cross_norm': g_cross_norm[l], 'g_mem_norm': g_mem_norm[l],
            'w_cq': w_cq[l], 'w_ck': w_ck[l], 'w_cv': w_cv[l], 'g_cqn': g_cqn[l], 'g_ckn': g_ckn[l],
            'w_co': w_co[l], 'g_ffn_norm': g_ffn_norm[l], 'w_gate': w_gate[l], 'w_up': w_up[l],
            'w_down': w_down[l],
        }
        mk, mv = memory_kv(mem_prompt, w)
        xp, ka, va, st, lat, kr = trunk_layer(xp, empty_kv, empty_kv, zero_state, empty_lat, empty_kr, mk, mv, w)
        p_k.append(ka)
        p_v.append(va)
        p_s.append(st)
        p_lat.append(lat)
        p_kr.append(kr)
        p_mk.append(mk)
        p_mv.append(mv)
        xs, ka, va, st, lat, kr = trunk_layer(xs, cache_sb_k[l], cache_sb_v[l], state_gla[l],
                                              cache_mla_latent[l], cache_mla_krope[l],
                                              cache_mem_k[l], cache_mem_v[l], w)
        s_k.append(ka)
        s_v.append(va)
        s_s.append(st)
        s_lat.append(lat)
        s_kr.append(kr)
    new_sb_k_prompt = jnp.stack(p_k)
    new_sb_v_prompt = jnp.stack(p_v)
    new_state_gla_prompt = jnp.stack(p_s)
    new_mla_latent_prompt = jnp.stack(p_lat)
    new_mla_krope_prompt = jnp.stack(p_kr)
    new_mem_k_prompt = jnp.stack(p_mk)
    new_mem_v_prompt = jnp.stack(p_mv)
    new_sb_k_sample = jnp.stack(s_k)
    new_sb_v_sample = jnp.stack(s_v)
    new_state_gla_sample = jnp.stack(s_s)
    new_mla_latent_sample = jnp.stack(s_lat)
    new_mla_krope_sample = jnp.stack(s_kr)
    return (xp, xs, new_sb_k_prompt, new_sb_v_prompt, new_state_gla_prompt, new_mla_latent_prompt,
            new_mla_krope_prompt, new_mem_k_prompt, new_mem_v_prompt, new_sb_k_sample, new_sb_v_sample,
            new_state_gla_sample, new_mla_latent_sample, new_mla_krope_sample)
```

```cpp
#include <hip/hip_runtime.h>
#include <hip/hip_cooperative_groups.h>
#include <stdint.h>
#include <stdio.h>
namespace cg = cooperative_groups;

#ifndef REP_MASK
#define REP_MASK 0
#endif
#ifndef SB_PF
#define SB_PF true
#endif
#ifndef CR_PF
#define CR_PF false
#endif
#ifndef ONE_LAUNCH
#define ONE_LAUNCH 1
#endif

typedef unsigned short bf16_t;
typedef short bf16x8 __attribute__((ext_vector_type(8)));
typedef short s16x4 __attribute__((ext_vector_type(4)));
typedef float f32x16 __attribute__((ext_vector_type(16)));
typedef float f32x2 __attribute__((ext_vector_type(2)));
typedef __bf16 bf16x2n __attribute__((ext_vector_type(2)));
#define DI __device__ __forceinline__
#define MFMA32(a, b, c) __builtin_amdgcn_mfma_f32_32x32x16_bf16((a), (b), (c), 0, 0, 0)

constexpr int R_P = 16384, R_S = 2048, R_ALL = 18432;
constexpr int NPAST = 131072;
constexpr float EPS = 1e-6f;
constexpr float LOG2E = 1.4426950408889634f;
constexpr float LN2 = 0.6931471805599453f;

constexpr size_t O_Y = 0;
constexpr size_t O_SBK_P = 18874368;
constexpr size_t O_SBV_P = O_SBK_P + 8388608;
constexpr size_t O_GLA_P = O_SBV_P + 8388608;
constexpr size_t O_LAT_P = O_GLA_P + 65536;
constexpr size_t O_KR_P = O_LAT_P + 4194304;
constexpr size_t O_MEMK_P = O_KR_P + 1048576;
constexpr size_t O_MEMV_P = O_MEMK_P + 1048576;
constexpr size_t O_SBK_S = O_MEMV_P + 1048576;
constexpr size_t O_SBV_S = O_SBK_S + 1048576;
constexpr size_t O_GLA_S = O_SBV_S + 1048576;
constexpr size_t O_LAT_S = O_GLA_S + 524288;
constexpr size_t O_KR_S = O_LAT_S + 524288;

constexpr size_t W_IN = 0;
constexpr size_t W_UQ = W_IN + 2048 * 1024;
constexpr size_t W_UKV = W_UQ + 768 * 256;
constexpr size_t W_OUT = W_UKV + 1024 * 128;
constexpr size_t W_CQ = W_OUT + 1024 * 1024;
constexpr size_t W_CK = W_CQ + 512 * 1024;
constexpr size_t W_CV = W_CK + 512 * 1024;
constexpr size_t W_CO = W_CV + 512 * 1024;
constexpr size_t W_GU = W_CO + 1024 * 512;
constexpr size_t W_DN = W_GU + 5632 * 1024;
constexpr size_t W_LAYER = W_DN + 1024 * 2816;

constexpr size_t al256(size_t x) { return (x + 255) & ~(size_t)255; }
constexpr size_t WS_W = 0;
constexpr size_t WS_XB = al256(WS_W + 2 * W_LAYER * 2);
constexpr size_t WS_SSQ = al256(WS_XB + (size_t)R_ALL * 1024 * 2);
constexpr size_t WS_PROJ = al256(WS_SSQ + (size_t)R_ALL * 16 * 4);
constexpr size_t WS_CQN = al256(WS_PROJ + (size_t)R_ALL * 2048 * 2);
constexpr size_t WS_LATB = al256(WS_CQN + (size_t)R_ALL * 256 * 2);
constexpr size_t WS_KRB = al256(WS_LATB + (size_t)R_ALL * 128 * 2);
constexpr size_t WS_QN = al256(WS_KRB + (size_t)R_ALL * 32 * 2);
constexpr size_t WS_QR = al256(WS_QN + (size_t)R_ALL * 512 * 2);
constexpr size_t WS_KNB = al256(WS_QR + (size_t)R_ALL * 256 * 2);
constexpr size_t WS_VB = al256(WS_KNB + (size_t)R_ALL * 512 * 2);
constexpr size_t WS_MIX = al256(WS_VB + (size_t)R_ALL * 512 * 2);
constexpr size_t WS_QC = al256(WS_MIX + (size_t)R_ALL * 1024 * 2);
constexpr size_t WS_OC = al256(WS_QC + (size_t)R_ALL * 512 * 2);
constexpr size_t WS_ACT = al256(WS_OC + (size_t)R_ALL * 512 * 2);
constexpr size_t WS_MEMB = al256(WS_ACT + (size_t)R_ALL * 2816 * 2);
constexpr size_t WS_MEMKP = al256(WS_MEMB + (size_t)1024 * 1024 * 2);
constexpr size_t WS_MEMVP = al256(WS_MEMKP + (size_t)2 * 1024 * 512 * 2);
constexpr size_t WS_MEMKS = al256(WS_MEMVP + (size_t)2 * 1024 * 512 * 2);
constexpr size_t WS_MEMVS = al256(WS_MEMKS + (size_t)2 * 8192 * 512 * 2);
constexpr size_t WS_LATP = al256(WS_MEMVS + (size_t)2 * 8192 * 512 * 2);
constexpr size_t WS_KRP = al256(WS_LATP + (size_t)2 * NPAST * 128 * 2);
constexpr size_t WS_KNP = al256(WS_KRP + (size_t)2 * NPAST * 32 * 2);
constexpr size_t WS_VP = al256(WS_KNP + (size_t)NPAST * 512 * 2);
constexpr size_t WS_GLAB = al256(WS_VP + (size_t)NPAST * 512 * 2);
constexpr size_t WS_GLOC = al256(WS_GLAB + (size_t)1152 * 2048 * 4);
constexpr size_t WS_GDEC = al256(WS_GLOC + (size_t)1152 * 2048 * 4);
constexpr size_t WS_GST = al256(WS_GDEC + (size_t)1152 * 32 * 4);
constexpr size_t WS_BAR = al256(WS_GST + (size_t)1152 * 2048 * 4);
constexpr size_t WS_CNT = al256(WS_BAR + 3456 * 4);
constexpr size_t WS_END = al256(WS_CNT + 256);

constexpr int SMEM_BYTES = 77824;
constexpr int NPHASE = 21;

struct Params {
    const float* in[38];
    float* out;
    unsigned char* ws;
    int phase_begin, phase_end;
};

__constant__ double ROPE_REV[16] = {0.15915494309189535, 0.08949940160889101, 0.050329212104487035, 0.0283021958306234,
                                    0.015915494309189534, 0.008949940160889102, 0.005032921210448704, 0.00283021958306234,
                                    0.0015915494309189536, 0.0008949940160889102, 0.0005032921210448703, 0.00028302195830623395,
                                    0.00015915494309189535, 8.949940160889102e-05, 5.0329212104487035e-05, 2.8302195830623396e-05};

typedef unsigned u32x4 __attribute__((ext_vector_type(4)));
DI u32x4 gload16_async(const void* p) { u32x4 v; asm volatile("global_load_dwordx4 %0, %1, off" : "=v"(v) : "v"(p) : "memory"); return v; }
DI u32x4 gload16_async_nt(const void* p) { u32x4 v; asm volatile("global_load_dwordx4 %0, %1, off nt" : "=v"(v) : "v"(p) : "memory"); return v; }
DI void wait_vm0() { asm volatile("s_waitcnt vmcnt(0)" ::: "memory"); }
DI int otid() { int t = threadIdx.x; asm volatile("" : "+v"(t)); return t; }
DI float bf2f(bf16_t v) { return __uint_as_float(((unsigned)v) << 16); }
DI unsigned pack2(float a, float b) { f32x2 v = {a, b}; bf16x2n r = __builtin_convertvector(v, bf16x2n); return __builtin_bit_cast(unsigned, r); }
DI float lo16(unsigned u) { return __uint_as_float(u << 16); }
DI float hi16(unsigned u) { return __uint_as_float(u & 0xffff0000u); }
DI float wave_sum(float v) {
#pragma unroll
    for (int o = 32; o; o >>= 1) v += __shfl_xor(v, o);
    return v;
}
DI int crow(int i, int h) { return (i & 3) + 8 * (i >> 2) + 4 * h; }
DI void tile_map(const int q, const int NTN, int& tm, int& tn) { const int per = 8 * NTN; const int grp = q / per, rem = q - grp * per; tn = rem >> 3; tm = grp * 8 + (rem & 7); }
DI void rope_cs(int pos, int f, float& c, float& s) {
    double rev = (double)pos * ROPE_REV[f];
    rev -= rint(rev);
    float fr = (float)rev;
    c = __builtin_amdgcn_cosf(fr);
    s = __builtin_amdgcn_sinf(fr);
}
DI int row_pos(int row) { return row < R_P ? (row & 4095) : 4096 + ((row - R_P) & 63); }
DI float silu(float x) { return x * __builtin_amdgcn_rcpf(1.f + __builtin_amdgcn_exp2f(-x * LOG2E)); }
DI uint4 cvt8(const float* p) {
    float4 a = *(const float4*)p, b = *(const float4*)(p + 4);
    uint4 r; r.x = pack2(a.x, a.y); r.y = pack2(a.z, a.w); r.z = pack2(b.x, b.y); r.w = pack2(b.z, b.w); return r;
}


#define XB_TMO      128
#define XB_XCNT(j)  (256  + 64 * (j))
#define XB_XSUB(j)  (1280 + 64 * (j))
#define XB_XGEN(j)  (2304 + 64 * (j))
#define XB_TOP      3328
#define XB_TOPGEN   3392
#define XCD_BAR_WORDS 3456
#define XB_SPIN_CAP (1u << 20)
#define LAS __attribute__((address_space(3)))
DI unsigned xb_ld(unsigned* p) { return __hip_atomic_load(p, __ATOMIC_RELAXED, __HIP_MEMORY_SCOPE_AGENT); }
DI unsigned xb_add(unsigned* p, unsigned v) { return __hip_atomic_fetch_add(p, v, __ATOMIC_RELAXED, __HIP_MEMORY_SCOPE_AGENT); }
DI unsigned xb_xcc_id() { return (unsigned)__builtin_amdgcn_s_getreg((3 << 11) | 20) & 0xFu; }
#define XB_SPIN(cond, bar) do { unsigned _sp = 0; while (cond) { __builtin_amdgcn_s_sleep(1); \
    if ((++_sp & 255u) == 0u) { if (xb_ld(&(bar)[XB_TMO])) break; if (_sp > XB_SPIN_CAP) { atomicAdd(&(bar)[XB_TMO], 1u); break; } } } } while (0)
struct XcdBarrier { unsigned* bar; unsigned x; volatile LAS unsigned* st; };
DI XcdBarrier xcd_barrier_post(unsigned* bar, volatile LAS unsigned* st) {
    XcdBarrier b; b.bar = bar; b.x = xb_xcc_id(); b.st = st;
    if (threadIdx.x == 0) (void)xb_add(&bar[XB_XCNT(b.x)], 1u);
    return b;
}
DI void xcd_barrier_complete(unsigned* bar, unsigned x, unsigned& nloc, unsigned& nx) {
    const unsigned G = gridDim.x * gridDim.y * gridDim.z;
    unsigned sum, cnt, mine, sp = 0u;
    for (;;) {
        sum = 0u; cnt = 0u; mine = 0u;
#pragma unroll
        for (unsigned j = 0; j < 16; ++j) { const unsigned c = xb_ld(&bar[XB_XCNT(j)]); sum += c; cnt += (c > 0u) ? 1u : 0u; mine = (j == x) ? c : mine; }
        if (sum == G) break;
        __builtin_amdgcn_s_sleep(1);
        if ((++sp & 255u) == 0u) { if (xb_ld(&bar[XB_TMO])) break; if (sp > XB_SPIN_CAP) { atomicAdd(&bar[XB_TMO], 1u); break; } }
    }
    nloc = mine > 0u ? mine : 1u; nx = cnt > 0u ? cnt : 1u;
}
DI void xcd_barrier(const XcdBarrier& b) {
    asm volatile("s_waitcnt vmcnt(0)" ::: "memory");
    __syncthreads();
    if (threadIdx.x == 0) {
        unsigned* bar = b.bar;
        __builtin_amdgcn_s_waitcnt(0);
        unsigned nloc = b.st[0], nx = b.st[1];
        if (nloc == 0u) { xcd_barrier_complete(bar, b.x, nloc, nx); b.st[0] = nloc; b.st[1] = nx; }
        const unsigned old = xb_add(&bar[XB_XSUB(b.x)], 1u);
        const unsigned gen = old / nloc;
        if (old + 1u == (gen + 1u) * nloc) {
            __builtin_amdgcn_fence(__ATOMIC_RELEASE, "agent");
            asm volatile("s_waitcnt vmcnt(0)" ::: "memory");
            const unsigned og = xb_add(&bar[XB_TOP], 1u);
            const unsigned tg = og / nx;
            if (og + 1u == (tg + 1u) * nx) xb_add(&bar[XB_TOPGEN], 1u);
            else XB_SPIN(xb_ld(&bar[XB_TOPGEN]) == tg, bar);
            __builtin_amdgcn_fence(__ATOMIC_ACQUIRE, "agent");
            xb_add(&bar[XB_XGEN(b.x)], 1u);
            asm volatile("s_waitcnt vmcnt(0)" ::: "memory");
        } else {
            XB_SPIN(xb_ld(&bar[XB_XGEN(b.x)]) == gen, bar);
            __builtin_amdgcn_fence(__ATOMIC_ACQUIRE, "agent");
            asm volatile("s_waitcnt vmcnt(0)" ::: "memory");
        }
    }
    __syncthreads();
}

DI void prep_weight_tile(const Params& P, int j, unsigned char* smem) {
    float* tile = (float*)smem;
    const int l = j / 3472; int t = j % 3472;
    int wid, KT, ldsrc; size_t woff; const float* src; const float* src2 = nullptr; const float* gain = nullptr; int Kd;
    if (t < 512) { wid = 0; KT = 16; ldsrc = 1968; woff = W_IN; src = P.in[11] + (size_t)l * 1024 * 1968; gain = P.in[10] + l * 1024; Kd = 1024; }
    else if (t < 560) { t -= 512; wid = 1; KT = 4; ldsrc = 768; woff = W_UQ; src = P.in[17] + (size_t)l * 256 * 768; gain = P.in[16] + l * 256; Kd = 256; }
    else if (t < 592) { t -= 560; wid = 2; KT = 2; ldsrc = 1024; woff = W_UKV; src = P.in[22] + (size_t)l * 128 * 1024; Kd = 128; }
    else if (t < 848) { t -= 592; wid = 3; KT = 16; ldsrc = 1024; woff = W_OUT; src = P.in[25] + (size_t)l * 1024 * 1024; Kd = 1024; }
    else if (t < 976) { t -= 848; wid = 4; KT = 16; ldsrc = 512; woff = W_CQ; src = P.in[28] + (size_t)l * 1024 * 512; gain = P.in[26] + l * 1024; Kd = 1024; }
    else if (t < 1104) { t -= 976; wid = 5; KT = 16; ldsrc = 512; woff = W_CK; src = P.in[29] + (size_t)l * 1024 * 512; gain = P.in[27] + l * 1024; Kd = 1024; }
    else if (t < 1232) { t -= 1104; wid = 6; KT = 16; ldsrc = 512; woff = W_CV; src = P.in[30] + (size_t)l * 1024 * 512; gain = P.in[27] + l * 1024; Kd = 1024; }
    else if (t < 1360) { t -= 1232; wid = 7; KT = 8; ldsrc = 1024; woff = W_CO; src = P.in[33] + (size_t)l * 512 * 1024; Kd = 512; }
    else if (t < 2768) { t -= 1360; wid = 8; KT = 16; ldsrc = 2816; woff = W_GU; src = P.in[35] + (size_t)l * 1024 * 2816; src2 = P.in[36] + (size_t)l * 1024 * 2816; gain = P.in[34] + l * 1024; Kd = 1024; }
    else { t -= 2768; wid = 9; KT = 44; ldsrc = 1024; woff = W_DN; src = P.in[37] + (size_t)l * 2816 * 1024; Kd = 2816; }
    const int nt = t / KT, kt = t % KT;
    const int n0 = nt * 64, k0 = kt * 64;
    const int tid = otid();
    {
        const int tx = tid & 63, ty = tid >> 6;
        const int n = n0 + tx;
        int sc = n; const float* s = src;
        if (wid == 0) { sc = n < 1280 ? n : (n < 1952 ? n + 16 : (n < 1968 ? n - 672 : -1)); }
        else if (wid == 1) { if (n < 512) sc = (n >> 6) * 96 + (n & 63); else { int c = n - 512; sc = (c >> 5) * 96 + 64 + (c & 31); } }
        else if (wid == 2) { if (n < 512) sc = (n >> 6) * 128 + (n & 63); else { int c = n - 512; sc = (c >> 6) * 128 + 64 + (c & 63); } }
        else if (wid == 8) { int blk = n >> 6, w = n & 63; sc = blk * 32 + (w & 31); if (w >= 32) s = src2; }
        float vals[16];
#pragma unroll
        for (int i = 0; i < 16; ++i) {
            const int kk = ty + 4 * i;
            vals[i] = (sc >= 0) ? s[(size_t)(k0 + kk) * ldsrc + sc] : 0.f;
        }
        if (gain) {
#pragma unroll
            for (int i = 0; i < 16; ++i) vals[i] *= gain[k0 + ty + 4 * i];
        }
#pragma unroll
        for (int i = 0; i < 16; ++i) tile[(ty + 4 * i) * 65 + tx] = vals[i];
    }
    __syncthreads();
    {
        bf16_t* Wt = (bf16_t*)(P.ws + WS_W) + (size_t)l * W_LAYER + woff;
#pragma unroll
        for (int i = 0; i < 2; ++i) {
            const int c = tid + 256 * i, nn = c >> 3, kc = c & 7;
            const float* tp = tile + (kc * 8) * 65 + nn;
            u32x4 v;
            v.x = pack2(tp[0], tp[65]); v.y = pack2(tp[130], tp[195]); v.z = pack2(tp[260], tp[325]); v.w = pack2(tp[390], tp[455]);
            *(u32x4*)(Wt + (size_t)(n0 + nn) * Kd + k0 + kc * 8) = v;
        }
    }
    __syncthreads();
}

DI void prep_x_rows(const Params& P, int j) {
    const int tid_ = otid(); const int lane = tid_ & 63, wave = tid_ >> 6;
    const int row = j * 4 + wave;
    const float* src = row < R_P ? P.in[0] + (size_t)row * 1024 : P.in[1] + (size_t)(row - R_P) * 1024;
    float* y = P.out + O_Y + (size_t)row * 1024;
    bf16_t* xb = (bf16_t*)(P.ws + WS_XB) + (size_t)row * 1024;
    float ss = 0.f;
#pragma unroll
    for (int i = 0; i < 4; ++i) {
        const int c = i * 256 + lane * 4;
        float4 v = *(const float4*)(src + c);
        *(float4*)(y + c) = v;
        uint2 b; b.x = pack2(v.x, v.y); b.y = pack2(v.z, v.w);
        *(uint2*)(xb + c) = b;
        ss += v.x * v.x + v.y * v.y + v.z * v.z + v.w * v.w;
    }
    ss = wave_sum(ss);
    float* sq = (float*)(P.ws + WS_SSQ) + (size_t)row * 16;
    if (lane < 16) sq[lane] = lane == 0 ? ss : 0.f;
}
DI void prep_mem_rows(const Params& P, int j) {
    const int tid_ = otid(); const int lane = tid_ & 63, wave = tid_ >> 6;
    const int row = j * 4 + wave;
    const float* src = P.in[2] + (size_t)row * 1024;
    bf16_t* mb = (bf16_t*)(P.ws + WS_MEMB) + (size_t)row * 1024;
    float4 v[4]; float ss = 0.f;
#pragma unroll
    for (int i = 0; i < 4; ++i) { v[i] = *(const float4*)(src + i * 256 + lane * 4); ss += v[i].x * v[i].x + v[i].y * v[i].y + v[i].z * v[i].z + v[i].w * v[i].w; }
    ss = wave_sum(ss);
    const float rinv = __builtin_amdgcn_rsqf(ss * (1.f / 1024.f) + EPS);
#pragma unroll
    for (int i = 0; i < 4; ++i) { uint2 b; b.x = pack2(v[i].x * rinv, v[i].y * rinv); b.y = pack2(v[i].z * rinv, v[i].w * rinv); *(uint2*)(mb + i * 256 + lane * 4) = b; }
}
DI void prep_convert(const Params& P, int j) {
    const float* src; bf16_t* dst; size_t off;
    if (j < 4096) { src = P.in[6]; dst = (bf16_t*)(P.ws + WS_LATP); off = (size_t)j * 8192; }
    else if (j < 5120) { src = P.in[7]; dst = (bf16_t*)(P.ws + WS_KRP); off = (size_t)(j - 4096) * 8192; }
    else if (j < 6144) { src = P.in[8]; dst = (bf16_t*)(P.ws + WS_MEMKS); off = (size_t)(j - 5120) * 8192; }
    else { src = P.in[9]; dst = (bf16_t*)(P.ws + WS_MEMVS); off = (size_t)(j - 6144) * 8192; }
    off += otid() * 8;
    float4 a[4], b[4];
#pragma unroll
    for (int i = 0; i < 4; ++i) { a[i] = *(const float4*)(src + off + i * 2048); b[i] = *(const float4*)(src + off + i * 2048 + 4); }
#pragma unroll
    for (int i = 0; i < 4; ++i) { uint4 r; r.x = pack2(a[i].x, a[i].y); r.y = pack2(a[i].z, a[i].w); r.z = pack2(b[i].x, b[i].y); r.w = pack2(b[i].z, b[i].w); *(uint4*)(dst + off + i * 2048) = r; }
}

enum { E_PROJ = 0, E_UQ, E_KV, E_RES, E_CQ, E_MEMK, E_MEMV, E_GU };

template <int EPI, int MT = 2>
DI void gemm_tile(const Params& P, const int l, const bf16_t* __restrict__ A, const int lda, const bf16_t* __restrict__ Bt, const int K,
                  const int tm, const int tn, unsigned char* smem, const int variant) {
    const int tid = otid(), lane = tid & 63, wave = tid >> 6, r = lane & 31, h = lane >> 5;
    const int wm = wave & 1, wn = wave >> 1;
    const bf16_t* Ag = A + (size_t)(tm * (64 * MT)) * lda;
    const bf16_t* Bg = Bt + (size_t)(tn * 128) * K;
    const int lrow = tid >> 3, lcc = tid & 7;
    f32x16 acc[2][MT];
#pragma unroll
    for (int a = 0; a < 2; ++a)
#pragma unroll
        for (int b = 0; b < MT; ++b)
#pragma unroll
            for (int i = 0; i < 16; ++i) acc[a][b][i] = 0.f;
    const int nk = K >> 6;
    constexpr int STGB = (64 * MT + 128) * 128;
    constexpr int BOFF = 64 * MT * 128;
    const int xr = (r >> 1) & 7;
    const int srow = lane >> 3;
    const int spos = lane & 7;
#define GLDS_ISSUE(STG, KT) { const int k0_ = (KT) * 64; unsigned char* sb_ = smem + (STG) * STGB; \
        _Pragma("unroll") for (int i = 0; i < 2 * MT; ++i) { const int blk = i * 4 + wave; const int row = blk * 8 + srow; const int c = spos ^ ((row >> 1) & 7); \
            __builtin_amdgcn_global_load_lds((const unsigned*)(Ag + (size_t)row * lda + k0_ + c * 8), (unsigned*)(sb_ + blk * 1024 + lane * 16), 16, 0, 0); } \
        _Pragma("unroll") for (int i = 0; i < 4; ++i) { const int blk = i * 4 + wave; const int row = blk * 8 + srow; const int c = spos ^ ((row >> 1) & 7); \
            __builtin_amdgcn_global_load_lds((const unsigned*)(Bg + (size_t)row * K + k0_ + c * 8), (unsigned*)(sb_ + BOFF + blk * 1024 + lane * 16), 16, 0, 0); } }
#define GLDS_FR(FS, STG, KS) { const unsigned char* cur = smem + (STG) * STGB; const int co = (((2 * (KS) + h) ^ xr) * 16); \
        _Pragma("unroll") for (int nt = 0; nt < 2; ++nt) bfr[FS][nt] = *(const bf16x8*)(cur + BOFF + (wn * 64 + 32 * nt + r) * 128 + co); \
        _Pragma("unroll") for (int mt = 0; mt < MT; ++mt) afr[FS][mt] = *(const bf16x8*)(cur + (wm * (32 * MT) + 32 * mt + r) * 128 + co); }
#define GEMM_MM(FS) { _Pragma("unroll") for (int nt = 0; nt < 2; ++nt) _Pragma("unroll") for (int mt = 0; mt < MT; ++mt) acc[nt][mt] = MFMA32(bfr[FS][nt], afr[FS][mt], acc[nt][mt]); }
    bf16x8 bfr[2][2], afr[2][MT];
    GLDS_ISSUE(0, 0);
    __syncthreads();
    for (int kt = 0; kt < nk; ++kt) {
        const int st = kt & 1;
        if (kt + 1 < nk) GLDS_ISSUE(st ^ 1, kt + 1);
        GLDS_FR(0, st, 0);
        GLDS_FR(1, st, 1); GEMM_MM(0);
        GLDS_FR(0, st, 2); GEMM_MM(1);
        GLDS_FR(1, st, 3); GEMM_MM(0);
        GEMM_MM(1);
        __syncthreads();
    }
#undef GLDS_ISSUE
#undef GLDS_FR
#undef GEMM_MM
    const int rowb = tm * (64 * MT) + wm * (32 * MT) + r;
    const int colb = tn * 128 + wn * 64 + 4 * h;
    float rinv[MT];
#pragma unroll
    for (int mt = 0; mt < MT; ++mt) rinv[mt] = 1.f;
    if (EPI == E_PROJ || EPI == E_CQ || EPI == E_GU) {
        const float* sq = (const float*)(P.ws + WS_SSQ);
#pragma unroll
        for (int mt = 0; mt < MT; ++mt) {
            const float4* p4 = (const float4*)(sq + (size_t)(rowb + 32 * mt) * 16);
            float4 a = p4[0], b = p4[1], c = p4[2], d = p4[3];
            float s = (a.x + a.y + a.z + a.w) + (b.x + b.y + b.z + b.w) + (c.x + c.y + c.z + c.w) + (d.x + d.y + d.z + d.w);
            rinv[mt] = __builtin_amdgcn_rsqf(s * (1.f / 1024.f) + EPS);
        }
    }
    if (EPI == E_PROJ) {
        bf16_t* pb = (bf16_t*)(P.ws + WS_PROJ);
        const bool kv = (tn >= 2 && tn < 6);
#pragma unroll
        for (int mt = 0; mt < MT; ++mt) {
            const int row = rowb + 32 * mt;
            float* fo = nullptr;
            if (kv) {
                const int isv = tn >= 4;
                if (row < R_P) fo = P.out + (isv ? O_SBV_P : O_SBK_P) + ((size_t)l * R_P + row) * 256;
                else fo = P.out + (isv ? O_SBV_S : O_SBK_S) + ((size_t)l * R_S + (row - R_P)) * 256;
                fo -= isv ? 512 : 256;
            }
#pragma unroll
            for (int nt = 0; nt < 2; ++nt)
#pragma unroll
                for (int g = 0; g < 4; ++g) {
                    const int col = colb + 32 * nt + 8 * g;
                    float v0 = acc[nt][mt][4 * g] * rinv[mt], v1 = acc[nt][mt][4 * g + 1] * rinv[mt], v2 = acc[nt][mt][4 * g + 2] * rinv[mt], v3 = acc[nt][mt][4 * g + 3] * rinv[mt];
                    uint2 b; b.x = pack2(v0, v1); b.y = pack2(v2, v3);
                    *(uint2*)(smem + (wm * (32 * MT) + 32 * mt + r) * 272 + (wn * 64 + 32 * nt + 8 * g + 4 * h) * 2) = b;
                    if (kv) *(float4*)(fo + col) = make_float4(v0, v1, v2, v3);
                }
        }
        __syncthreads();
#pragma unroll
        for (int it = 0; it < 4 * MT; ++it) {
            const int row = it * 16 + (tid >> 4), cc = tid & 15;
            const u32x4 v = *(const u32x4*)(smem + row * 272 + cc * 16);
            *(u32x4*)(pb + (size_t)(tm * (64 * MT) + row) * 2048 + tn * 128 + cc * 8) = v;
        }
        __syncthreads();
    } else if (EPI == E_UQ) {
        if (tn < 4) {
            bf16_t* qn = (bf16_t*)(P.ws + WS_QN);
            const float* g_qn = P.in[18] + l * 64;
            const float SC = 0.10206207261596575f * LOG2E;
            float4 ggq[2][4];
#pragma unroll
            for (int nt = 0; nt < 2; ++nt)
#pragma unroll
                for (int g = 0; g < 4; ++g) ggq[nt][g] = *(const float4*)(g_qn + 32 * nt + 8 * g + 4 * h);
#pragma unroll
            for (int mt = 0; mt < MT; ++mt) {
                const int row = rowb + 32 * mt;
                float ss = 0.f;
#pragma unroll
                for (int nt = 0; nt < 2; ++nt)
#pragma unroll
                    for (int i = 0; i < 16; ++i) ss += acc[nt][mt][i] * acc[nt][mt][i];
                ss += __shfl_xor(ss, 32);
                const float ri = __builtin_amdgcn_rsqf(ss * (1.f / 64.f) + EPS) * SC;
#pragma unroll
                for (int nt = 0; nt < 2; ++nt)
#pragma unroll
                    for (int g = 0; g < 4; ++g) {
                        const int d = 32 * nt + 8 * g + 4 * h;
                        const float4 gg = ggq[nt][g];
                        uint2 b; b.x = pack2(acc[nt][mt][4 * g] * ri * gg.x, acc[nt][mt][4 * g + 1] * ri * gg.y);
                        b.y = pack2(acc[nt][mt][4 * g + 2] * ri * gg.z, acc[nt][mt][4 * g + 3] * ri * gg.w);
                        *(uint2*)(qn + (size_t)row * 512 + tn * 128 + wn * 64 + d) = b;
                    }
            }
        } else {
            bf16_t* qr = (bf16_t*)(P.ws + WS_QR);
            const float* g_qr = P.in[19] + l * 32;
            const float SC = 0.10206207261596575f * LOG2E;
            float gqr[16];
#pragma unroll
            for (int i = 0; i < 16; ++i) gqr[i] = g_qr[crow(i, h)];
#pragma unroll
            for (int mt = 0; mt < MT; ++mt) {
                const int row = rowb + 32 * mt;
                const int pos = row_pos(row);
                float cs[8], sn[8];
#pragma unroll
                for (int i = 0; i < 8; ++i) rope_cs(pos, crow(i, h), cs[i], sn[i]);
#pragma unroll
                for (int nt = 0; nt < 2; ++nt) {
                    float ss = 0.f;
#pragma unroll
                    for (int i = 0; i < 16; ++i) ss += acc[nt][mt][i] * acc[nt][mt][i];
                    ss += __shfl_xor(ss, 32);
                    const float ri = __builtin_amdgcn_rsqf(ss * (1.f / 32.f) + EPS);
                    float y[16];
#pragma unroll
                    for (int i = 0; i < 16; ++i) y[i] = acc[nt][mt][i] * ri * gqr[i];
                    float o[16];
#pragma unroll
                    for (int i = 0; i < 8; ++i) { o[i] = (y[i] * cs[i] - y[i + 8] * sn[i]) * SC; o[i + 8] = (y[i] * sn[i] + y[i + 8] * cs[i]) * SC; }
                    const int cb = (tn - 4) * 128 + wn * 64 + 32 * nt;
#pragma unroll
                    for (int g = 0; g < 4; ++g) {
                        uint2 b; b.x = pack2(o[4 * g], o[4 * g + 1]); b.y = pack2(o[4 * g + 2], o[4 * g + 3]);
                        *(uint2*)(qr + (size_t)row * 256 + cb + 8 * g + 4 * h) = b;
                    }
                }
            }
        }
    } else if (EPI == E_KV) {
        bf16_t* dst = (bf16_t*)(P.ws + (tn < 4 ? (variant ? WS_KNP : WS_KNB) : (variant ? WS_VP : WS_VB)));
        const int dcol0 = (tn & 3) * 128;
        const float* g_kn = P.in[23] + l * 64;
#pragma unroll
        for (int mt = 0; mt < MT; ++mt) {
            float ri = 1.f;
            if (tn < 4) {
                float ss = 0.f;
#pragma unroll
                for (int nt = 0; nt < 2; ++nt)
#pragma unroll
                    for (int i = 0; i < 16; ++i) ss += acc[nt][mt][i] * acc[nt][mt][i];
                ss += __shfl_xor(ss, 32);
                ri = __builtin_amdgcn_rsqf(ss * (1.f / 64.f) + EPS);
            }
#pragma unroll
            for (int nt = 0; nt < 2; ++nt)
#pragma unroll
                for (int g = 0; g < 4; ++g) {
                    const int d = 32 * nt + 8 * g + 4 * h;
                    float4 gg = make_float4(1.f, 1.f, 1.f, 1.f);
                    if (tn < 4) gg = *(const float4*)(g_kn + d);
                    uint2 b; b.x = pack2(acc[nt][mt][4 * g] * ri * gg.x, acc[nt][mt][4 * g + 1] * ri * gg.y);
                    b.y = pack2(acc[nt][mt][4 * g + 2] * ri * gg.z, acc[nt][mt][4 * g + 3] * ri * gg.w);
                    *(uint2*)(smem + (wm * (32 * MT) + 32 * mt + r) * 272 + (wn * 64 + d) * 2) = b;
                }
        }
        __syncthreads();
#pragma unroll
        for (int it = 0; it < 4 * MT; ++it) {
            const int row = it * 16 + (tid >> 4), cc = tid & 15;
            const u32x4 v = *(const u32x4*)(smem + row * 272 + cc * 16);
            *(u32x4*)(dst + (size_t)(tm * (64 * MT) + row) * 512 + dcol0 + cc * 8) = v;
        }
        __syncthreads();
    } else if (EPI == E_RES) {
        float* x = P.out + O_Y;
        bf16_t* xb = (bf16_t*)(P.ws + WS_XB);
        float* sq = (float*)(P.ws + WS_SSQ);
        float* stg = (float*)smem;
#pragma unroll
        for (int nt = 0; nt < 2; ++nt)
#pragma unroll
            for (int g = 0; g < 4; ++g)
                *(float4*)(stg + (wm * 32 + r) * 132 + wn * 64 + 32 * nt + 8 * g + 4 * h) = make_float4(acc[nt][0][4 * g], acc[nt][0][4 * g + 1], acc[nt][0][4 * g + 2], acc[nt][0][4 * g + 3]);
        __syncthreads();
        const int l32 = tid & 31, rsub = tid >> 5;
        const int col = tn * 128 + l32 * 4;
        float4 xin[8];
#pragma unroll
        for (int it = 0; it < 8; ++it) xin[it] = *(const float4*)(x + ((size_t)tm * 64 + it * 8 + rsub) * 1024 + col);
#pragma unroll
        for (int it = 0; it < 8; ++it) {
            const int rl = it * 8 + rsub;
            const size_t row = (size_t)tm * 64 + rl;
            const float4 a = *(const float4*)(stg + rl * 132 + l32 * 4);
            float4 xo = xin[it];
            xo.x += a.x; xo.y += a.y; xo.z += a.z; xo.w += a.w;
            *(float4*)(x + row * 1024 + col) = xo;
            uint2 bb; bb.x = pack2(xo.x, xo.y); bb.y = pack2(xo.z, xo.w);
            *(uint2*)(xb + row * 1024 + col) = bb;
            float ss = xo.x * xo.x + xo.y * xo.y + xo.z * xo.z + xo.w * xo.w;
            ss += __shfl_xor(ss, 16); ss += __shfl_xor(ss, 8); ss += __shfl_xor(ss, 4); ss += __shfl_xor(ss, 2); ss += __shfl_xor(ss, 1);
            if (l32 < 2) sq[row * 16 + tn * 2 + l32] = l32 == 0 ? ss : 0.f;
        }
        __syncthreads();
    } else if (EPI == E_CQ || EPI == E_MEMK) {
        float* red = (float*)(smem + 73728);
        float ssl[MT];
#pragma unroll
        for (int mt = 0; mt < MT; ++mt) {
            float ss = 0.f;
#pragma unroll
            for (int nt = 0; nt < 2; ++nt)
#pragma unroll
                for (int i = 0; i < 16; ++i) { float v = acc[nt][mt][i] * rinv[mt]; acc[nt][mt][i] = v; ss += v * v; }
            ss += __shfl_xor(ss, 32);
            ssl[mt] = ss;
            if (h == 0) red[wn * 128 + wm * (32 * MT) + 32 * mt + r] = ss;
        }
        __syncthreads();
        const float* gn = (EPI == E_CQ ? P.in[31] : P.in[32]) + l * 128;
        const float SC = (EPI == E_CQ) ? 0.08838834764831845f * LOG2E : 1.f;
        float4 ggc[2][4];
#pragma unroll
        for (int nt = 0; nt < 2; ++nt)
#pragma unroll
            for (int g = 0; g < 4; ++g) ggc[nt][g] = *(const float4*)(gn + wn * 64 + 32 * nt + 8 * g + 4 * h);
#pragma unroll
        for (int mt = 0; mt < MT; ++mt) {
            const int row = rowb + 32 * mt;
            const float tot = ssl[mt] + red[(wn ^ 1) * 128 + wm * (32 * MT) + 32 * mt + r];
            const float ri = __builtin_amdgcn_rsqf(tot * (1.f / 128.f) + EPS) * SC;
#pragma unroll
            for (int nt = 0; nt < 2; ++nt)
#pragma unroll
                for (int g = 0; g < 4; ++g) {
                    const int d = wn * 64 + 32 * nt + 8 * g + 4 * h;
                    const float4 gg = ggc[nt][g];
                    const float v0 = acc[nt][mt][4 * g] * ri * gg.x, v1 = acc[nt][mt][4 * g + 1] * ri * gg.y, v2 = acc[nt][mt][4 * g + 2] * ri * gg.z, v3 = acc[nt][mt][4 * g + 3] * ri * gg.w;
                    uint2 b; b.x = pack2(v0, v1); b.y = pack2(v2, v3);
                    if (EPI == E_CQ) {
                        *(uint2*)((bf16_t*)(P.ws + WS_QC) + (size_t)row * 512 + tn * 128 + d) = b;
                    } else {
                        *(uint2*)((bf16_t*)(P.ws + WS_MEMKP) + ((size_t)l * 1024 + row) * 512 + tn * 128 + d) = b;
                        *(float4*)(P.out + O_MEMK_P + ((size_t)l * 1024 + row) * 512 + tn * 128 + d) = make_float4(v0, v1, v2, v3);
                    }
                }
        }
        __syncthreads();
    } else if (EPI == E_MEMV) {
#pragma unroll
        for (int mt = 0; mt < MT; ++mt) {
            const int row = rowb + 32 * mt;
#pragma unroll
            for (int nt = 0; nt < 2; ++nt)
#pragma unroll
                for (int g = 0; g < 4; ++g) {
                    const int col = colb + 32 * nt + 8 * g;
                    uint2 b; b.x = pack2(acc[nt][mt][4 * g], acc[nt][mt][4 * g + 1]); b.y = pack2(acc[nt][mt][4 * g + 2], acc[nt][mt][4 * g + 3]);
                    *(uint2*)((bf16_t*)(P.ws + WS_MEMVP) + ((size_t)l * 1024 + row) * 512 + col) = b;
                    *(float4*)(P.out + O_MEMV_P + ((size_t)l * 1024 + row) * 512 + col) = make_float4(acc[nt][mt][4 * g], acc[nt][mt][4 * g + 1], acc[nt][mt][4 * g + 2], acc[nt][mt][4 * g + 3]);
                }
        }
    } else if (EPI == E_GU) {
        bf16_t* act = (bf16_t*)(P.ws + WS_ACT);
#pragma unroll
        for (int mt = 0; mt < MT; ++mt) {
#pragma unroll
            for (int g = 0; g < 4; ++g) {
                float o[4];
#pragma unroll
                for (int e = 0; e < 4; ++e) { const float gt = acc[0][mt][4 * g + e] * rinv[mt], up = acc[1][mt][4 * g + e] * rinv[mt]; o[e] = silu(gt) * up; }
                uint2 b; b.x = pack2(o[0], o[1]); b.y = pack2(o[2], o[3]);
                *(uint2*)(smem + (wm * (32 * MT) + 32 * mt + r) * 144 + (wn * 32 + 8 * g + 4 * h) * 2) = b;
            }
        }
        __syncthreads();
#pragma unroll
        for (int it = 0; it < 2 * MT; ++it) {
            const int row = it * 32 + (tid >> 3), cc = tid & 7;
            const u32x4 v = *(const u32x4*)(smem + row * 144 + cc * 16);
            *(u32x4*)(act + (size_t)(tm * (64 * MT) + row) * 2816 + tn * 64 + cc * 8) = v;
        }
        __syncthreads();
    }
}

typedef float f32x4v __attribute__((ext_vector_type(4)));
#define MFMA16(a, b, c) __builtin_amdgcn_mfma_f32_16x16x32_bf16((a), (b), (c), 0, 0, 0)
template <int EPI, int MT>
DI void gemm_tile16(const Params& P, const int l, const bf16_t* __restrict__ A, const int lda, const bf16_t* __restrict__ Bt, const int K,
                    const int tm, const int tn, unsigned char* smem, const bool last_res = false) {
    constexpr int NMT = 2 * MT;
    const int tid = otid(), lane = tid & 63, wave = tid >> 6, i16 = lane & 15, quad = lane >> 4;
    const int wm = wave & 1, wn = wave >> 1;
    const bf16_t* Ag = A + (size_t)(tm * (64 * MT)) * lda;
    const bf16_t* Bg = Bt + (size_t)(tn * 128) * K;
    f32x4v acc[4][NMT];
#pragma unroll
    for (int a = 0; a < 4; ++a)
#pragma unroll
        for (int b = 0; b < NMT; ++b)
#pragma unroll
            for (int i = 0; i < 4; ++i) acc[a][b][i] = 0.f;
    float rinv[NMT];
#pragma unroll
    for (int mt = 0; mt < NMT; ++mt) rinv[mt] = 1.f;
    if (EPI == E_GU || EPI == E_PROJ) {
        const float* sq = (const float*)(P.ws + WS_SSQ);
#pragma unroll
        for (int mt = 0; mt < NMT; ++mt) {
            const float4* p4 = (const float4*)(sq + (size_t)(tm * (64 * MT) + wm * (32 * MT) + 16 * mt + i16) * 16);
            float4 a = p4[0], b = p4[1], c = p4[2], d = p4[3];
            float s = (a.x + a.y + a.z + a.w) + (b.x + b.y + b.z + b.w) + (c.x + c.y + c.z + c.w) + (d.x + d.y + d.z + d.w);
            rinv[mt] = __builtin_amdgcn_rsqf(s * (1.f / 1024.f) + EPS);
        }
    }
    const int nk = K >> 6;
    constexpr int STGB = (64 * MT + 128) * 128;
    constexpr int BOFF = 64 * MT * 128;
    const int xr = (i16 >> 1) & 7;
    const int srow = lane >> 3, spos = lane & 7;
#define G16_ISSUE(STG, KT) { const int k0_ = (KT) * 64; unsigned char* sb_ = smem + (STG) * STGB; \
        _Pragma("unroll") for (int i = 0; i < 2 * MT; ++i) { const int blk = i * 4 + wave; const int row = blk * 8 + srow; const int c = spos ^ ((row >> 1) & 7); \
            __builtin_amdgcn_global_load_lds((const unsigned*)(Ag + (size_t)row * lda + k0_ + c * 8), (unsigned*)(sb_ + blk * 1024 + lane * 16), 16, 0, 0); } \
        _Pragma("unroll") for (int i = 0; i < 4; ++i) { const int blk = i * 4 + wave; const int row = blk * 8 + srow; const int c = spos ^ ((row >> 1) & 7); \
            __builtin_amdgcn_global_load_lds((const unsigned*)(Bg + (size_t)row * K + k0_ + c * 8), (unsigned*)(sb_ + BOFF + blk * 1024 + lane * 16), 16, 0, 0); } }
#define G16_FR(FS, STG, KS) { const unsigned char* cur = smem + (STG) * STGB; const int co = (((4 * (KS) + quad) ^ xr) * 16); \
        _Pragma("unroll") for (int nt = 0; nt < 4; ++nt) wfr[FS][nt] = *(const bf16x8*)(cur + BOFF + (wn * 64 + 16 * nt + i16) * 128 + co); \
        _Pragma("unroll") for (int mt = 0; mt < NMT; ++mt) xfr[FS][mt] = *(const bf16x8*)(cur + (wm * (32 * MT) + 16 * mt + i16) * 128 + co); }
#define G16_MM(FS) { _Pragma("unroll") for (int nt = 0; nt < 4; ++nt) _Pragma("unroll") for (int mt = 0; mt < NMT; ++mt) acc[nt][mt] = MFMA16(wfr[FS][nt], xfr[FS][mt], acc[nt][mt]); }
    bf16x8 wfr[2][4], xfr[2][NMT];
    G16_ISSUE(0, 0);
    __syncthreads();
    for (int kt = 0; kt < nk; ++kt) {
        const int st = kt & 1;
        if (kt + 1 < nk) G16_ISSUE(st ^ 1, kt + 1);
        G16_FR(0, st, 0);
        G16_FR(1, st, 1); G16_MM(0);
        G16_MM(1);
        __syncthreads();
    }
#undef G16_ISSUE
#undef G16_FR
#undef G16_MM
    if (EPI == E_GU) {
        bf16_t* act = (bf16_t*)(P.ws + WS_ACT);
#pragma unroll
        for (int mt = 0; mt < NMT; ++mt)
#pragma unroll
            for (int nt = 0; nt < 2; ++nt) {
                float o[4];
#pragma unroll
                for (int e = 0; e < 4; ++e) { const float gt = acc[nt][mt][e] * rinv[mt], up = acc[nt + 2][mt][e] * rinv[mt]; o[e] = silu(gt) * up; }
                uint2 b; b.x = pack2(o[0], o[1]); b.y = pack2(o[2], o[3]);
                *(uint2*)(smem + (wm * (32 * MT) + 16 * mt + i16) * 144 + (wn * 32 + 16 * nt + 4 * quad) * 2) = b;
            }
        __syncthreads();
#pragma unroll
        for (int it = 0; it < 2 * MT; ++it) {
            const int row = it * 32 + (tid >> 3), cc = tid & 7;
            const u32x4 v = *(const u32x4*)(smem + row * 144 + cc * 16);
            *(u32x4*)(act + (size_t)(tm * (64 * MT) + row) * 2816 + tn * 64 + cc * 8) = v;
        }
        __syncthreads();
    } else if (EPI == E_PROJ) {
        bf16_t* pb = (bf16_t*)(P.ws + WS_PROJ);
        const bool kv = (tn >= 2 && tn < 6);
#pragma unroll
        for (int mt = 0; mt < NMT; ++mt) {
            const int rl = wm * (32 * MT) + 16 * mt + i16;
            const int row = tm * (64 * MT) + rl;
            float* fo = nullptr;
            if (kv) {
                const int isv = tn >= 4;
                if (row < R_P) fo = P.out + (isv ? O_SBV_P : O_SBK_P) + ((size_t)l * R_P + row) * 256;
                else fo = P.out + (isv ? O_SBV_S : O_SBK_S) + ((size_t)l * R_S + (row - R_P)) * 256;
                fo -= isv ? 512 : 256;
            }
#pragma unroll
            for (int nt = 0; nt < 4; ++nt) {
                const int cl = wn * 64 + 16 * nt + 4 * quad;
                const float v0 = acc[nt][mt][0] * rinv[mt], v1 = acc[nt][mt][1] * rinv[mt], v2 = acc[nt][mt][2] * rinv[mt], v3 = acc[nt][mt][3] * rinv[mt];
                uint2 bb; bb.x = pack2(v0, v1); bb.y = pack2(v2, v3);
                *(uint2*)(smem + rl * 272 + cl * 2) = bb;
                if (kv) *(float4*)(fo + tn * 128 + cl) = make_float4(v0, v1, v2, v3);
            }
        }
        __syncthreads();
#pragma unroll
        for (int it = 0; it < 4 * MT; ++it) {
            const int row = it * 16 + (tid >> 4), cc = tid & 15;
            const u32x4 v = *(const u32x4*)(smem + row * 272 + cc * 16);
            *(u32x4*)(pb + (size_t)(tm * (64 * MT) + row) * 2048 + tn * 128 + cc * 8) = v;
        }
        __syncthreads();
    } else {
        float* x = P.out + O_Y;
        bf16_t* xb = (bf16_t*)(P.ws + WS_XB);
        float* sq = (float*)(P.ws + WS_SSQ);
        float* stg = (float*)smem;
#pragma unroll
        for (int mt = 0; mt < NMT; ++mt)
#pragma unroll
            for (int nt = 0; nt < 4; ++nt)
                *(float4*)(stg + (wm * 32 + 16 * mt + i16) * 132 + wn * 64 + 16 * nt + 4 * quad) = make_float4(acc[nt][mt][0], acc[nt][mt][1], acc[nt][mt][2], acc[nt][mt][3]);
        __syncthreads();
        const int l32 = tid & 31, rsub = tid >> 5;
        const int col = tn * 128 + l32 * 4;
        float4 xin[8];
#pragma unroll
        for (int it = 0; it < 8; ++it) xin[it] = *(const float4*)(x + ((size_t)tm * 64 + it * 8 + rsub) * 1024 + col);
#pragma unroll
        for (int it = 0; it < 8; ++it) {
            const int rl = it * 8 + rsub;
            const size_t row = (size_t)tm * 64 + rl;
            const float4 a = *(const float4*)(stg + rl * 132 + l32 * 4);
            float4 xo = xin[it];
            xo.x += a.x; xo.y += a.y; xo.z += a.z; xo.w += a.w;
            *(float4*)(x + row * 1024 + col) = xo;
            if (!last_res) {
                uint2 bb; bb.x = pack2(xo.x, xo.y); bb.y = pack2(xo.z, xo.w);
                *(uint2*)(xb + row * 1024 + col) = bb;
                float ss = xo.x * xo.x + xo.y * xo.y + xo.z * xo.z + xo.w * xo.w;
                ss += __shfl_xor(ss, 16); ss += __shfl_xor(ss, 8); ss += __shfl_xor(ss, 4); ss += __shfl_xor(ss, 2); ss += __shfl_xor(ss, 1);
                if (l32 < 2) sq[row * 16 + tn * 2 + l32] = l32 == 0 ? ss : 0.f;
            }
        }
        __syncthreads();
    }
}

DI void kv_stream(const Params& P, const int l, const bf16_t* __restrict__ A, const bf16_t* __restrict__ Bt, const int first, const int count, unsigned char* smem) {
    const int tid = otid(), lane = tid & 63, wave = tid >> 6, r = lane & 31, h = lane >> 5;
    const int wm = wave & 1, wn = wave >> 1;
    const int lrow = tid >> 3, lcc = tid & 7;
    const int G = gridDim.x, B = blockIdx.x;
    const float* g_kn = P.in[23] + l * 64;
    float4 ggk[2][4];
#pragma unroll
    for (int nt = 0; nt < 2; ++nt)
#pragma unroll
        for (int g = 0; g < 4; ++g) ggk[nt][g] = *(const float4*)(g_kn + 32 * nt + 8 * g + 4 * h);
    u32x4 ra[2][4], rb[2][4];
    int tm, tn;
#define KVS_ISSUE(Q) { int tm_, tn_; tile_map(first + (Q), 8, tm_, tn_); const bf16_t* Ag = A + (size_t)(tm_ * 128) * 128; const bf16_t* Bg = Bt + (size_t)(tn_ * 128) * 128; \
        _Pragma("unroll") for (int s_ = 0; s_ < 2; ++s_) _Pragma("unroll") for (int i = 0; i < 4; ++i) { \
            ra[s_][i] = gload16_async(Ag + (size_t)(lrow + 32 * i) * 128 + s_ * 64 + lcc * 8); rb[s_][i] = gload16_async(Bg + (size_t)(lrow + 32 * i) * 128 + s_ * 64 + lcc * 8); } }
    int it = 0;
    int q = ((it * 8 + (B & 7)) * (G >> 3)) + (B >> 3);
    if (q < count) KVS_ISSUE(q);
    while (q < count) {
        tile_map(first + q, 8, tm, tn);
        wait_vm0();
#pragma unroll
        for (int s_ = 0; s_ < 2; ++s_)
#pragma unroll
            for (int i = 0; i < 4; ++i) {
                *(u32x4*)(smem + s_ * 36864 + (lrow + 32 * i) * 144 + lcc * 16) = ra[s_][i];
                *(u32x4*)(smem + s_ * 36864 + 18432 + (lrow + 32 * i) * 144 + lcc * 16) = rb[s_][i];
            }
        __syncthreads();
        ++it;
        const int qn = ((it * 8 + (B & 7)) * (G >> 3)) + (B >> 3);
        if (qn < count) KVS_ISSUE(qn);
        f32x16 acc[2][2];
#pragma unroll
        for (int a = 0; a < 2; ++a)
#pragma unroll
            for (int b = 0; b < 2; ++b)
#pragma unroll
                for (int i = 0; i < 16; ++i) acc[a][b][i] = 0.f;
#pragma unroll
        for (int kk = 0; kk < 8; ++kk) {
            const unsigned char* cur = smem + (kk >> 2) * 36864;
            const int ks = kk & 3;
            bf16x8 bf[2], af[2];
#pragma unroll
            for (int nt = 0; nt < 2; ++nt) bf[nt] = *(const bf16x8*)(cur + 18432 + (wn * 64 + 32 * nt + r) * 144 + (16 * ks + 8 * h) * 2);
#pragma unroll
            for (int mt = 0; mt < 2; ++mt) af[mt] = *(const bf16x8*)(cur + (wm * 64 + 32 * mt + r) * 144 + (16 * ks + 8 * h) * 2);
#pragma unroll
            for (int nt = 0; nt < 2; ++nt)
#pragma unroll
                for (int mt = 0; mt < 2; ++mt) acc[nt][mt] = MFMA32(bf[nt], af[mt], acc[nt][mt]);
        }
        __syncthreads();
        bf16_t* dst = (bf16_t*)(P.ws + (tn < 4 ? WS_KNP : WS_VP));
        const int dcol0 = (tn & 3) * 128;
#pragma unroll
        for (int mt = 0; mt < 2; ++mt) {
            float ri = 1.f;
            if (tn < 4) {
                float ss = 0.f;
#pragma unroll
                for (int nt = 0; nt < 2; ++nt)
#pragma unroll
                    for (int i = 0; i < 16; ++i) ss += acc[nt][mt][i] * acc[nt][mt][i];
                ss += __shfl_xor(ss, 32);
                ri = __builtin_amdgcn_rsqf(ss * (1.f / 64.f) + EPS);
            }
#pragma unroll
            for (int nt = 0; nt < 2; ++nt)
#pragma unroll
                for (int g = 0; g < 4; ++g) {
                    float4 gg = make_float4(1.f, 1.f, 1.f, 1.f);
                    if (tn < 4) gg = ggk[nt][g];
                    uint2 b; b.x = pack2(acc[nt][mt][4 * g] * ri * gg.x, acc[nt][mt][4 * g + 1] * ri * gg.y);
                    b.y = pack2(acc[nt][mt][4 * g + 2] * ri * gg.z, acc[nt][mt][4 * g + 3] * ri * gg.w);
                    *(uint2*)(smem + (wm * 64 + 32 * mt + r) * 272 + (wn * 64 + 32 * nt + 8 * g + 4 * h) * 2) = b;
                }
        }
        __syncthreads();
#pragma unroll
        for (int i2 = 0; i2 < 8; ++i2) {
            const int row = i2 * 16 + (tid >> 4), cc = tid & 15;
            const u32x4 v = *(const u32x4*)(smem + row * 272 + cc * 16);
            *(u32x4*)(dst + (size_t)(tm * 128 + row) * 512 + dcol0 + cc * 8) = v;
        }
        __syncthreads();
        q = qn;
    }
#undef KVS_ISSUE
}

DI void rowpass(const Params& P, const int l, const int j) {
    const int tid_ = otid(); const int lane = tid_ & 63, wave = tid_ >> 6;
    const int row = j * 4 + wave;
    const bf16_t* pr = (const bf16_t*)(P.ws + WS_PROJ) + (size_t)row * 2048;
    const uint2 u_cq = *(const uint2*)(pr + 1536 + lane * 4);
    const unsigned u_ckv = *(const unsigned*)(pr + 1792 + lane * 2);
    const bf16_t u_kr = pr[1920 + (lane & 31)];
    const float2 g_ckv = *(const float2*)(P.in[21] + l * 128 + lane * 2);
    const float g_kr = P.in[20][l * 32 + (lane & 31)];
    {
        float a = lo16(u_cq.x), b = hi16(u_cq.x), c = lo16(u_cq.y), d = hi16(u_cq.y);
        float ss = wave_sum(a * a + b * b + c * c + d * d);
        const float ri = __builtin_amdgcn_rsqf(ss * (1.f / 256.f) + EPS);
        uint2 o; o.x = pack2(a * ri, b * ri); o.y = pack2(c * ri, d * ri);
        *(uint2*)((bf16_t*)(P.ws + WS_CQN) + (size_t)row * 256 + lane * 4) = o;
    }
    {
        float a = lo16(u_ckv), b = hi16(u_ckv);
        float ss = wave_sum(a * a + b * b);
        const float ri = __builtin_amdgcn_rsqf(ss * (1.f / 128.f) + EPS);
        a = a * ri * g_ckv.x; b = b * ri * g_ckv.y;
        float* fo = row < R_P ? P.out + O_LAT_P + ((size_t)l * R_P + row) * 128 : P.out + O_LAT_S + ((size_t)l * R_S + (row - R_P)) * 128;
        *(float2*)(fo + lane * 2) = make_float2(a, b);
        *(unsigned*)((bf16_t*)(P.ws + WS_LATB) + (size_t)row * 128 + lane * 2) = pack2(a, b);
    }
    {
        float v = lane < 32 ? bf2f(u_kr) : 0.f;
        float ss = wave_sum(v * v);
        const float ri = __builtin_amdgcn_rsqf(ss * (1.f / 32.f) + EPS);
        float y = v * ri * g_kr;
        float other = __shfl_xor(y, 16);
        float c, s; rope_cs(row_pos(row), lane & 15, c, s);
        float o = (lane & 16) ? (other * s + y * c) : (y * c - other * s);
        if (lane < 32) {
            float* fo = row < R_P ? P.out + O_KR_P + ((size_t)l * R_P + row) * 32 : P.out + O_KR_S + ((size_t)l * R_S + (row - R_P)) * 32;
            fo[lane] = o;
            ((bf16_t*)(P.ws + WS_KRB))[(size_t)row * 32 + lane] = (bf16_t)(pack2(o, 0.f) & 0xffff);
        }
    }
}

DI void gla_job_rows(int j, int& row0, int& h) {
    if (j < 1024) { row0 = (j >> 8) * 4096 + (j & 63) * 64; h = (j >> 6) & 3; }
    else { const int s = j - 1024; row0 = R_P + (s >> 2) * 64; h = s & 3; }
}
DI void gla_stepA(const Params& P, const int l, const int j, unsigned char* smem) {
    float* lb = (float*)smem;
    float* kk = lb + 64 * 33;
    float* vv = kk + 64 * 33;
    float* agl = vv + 64 * 64;
    const int tid = otid();
    int row0, h; gla_job_rows(j, row0, h);
    const bf16_t* pb = (const bf16_t*)(P.ws + WS_PROJ);
    if (tid < 128) {
        const int t = tid >> 1, half = tid & 1;
        const uint4 ua = *(const uint4*)(pb + (size_t)(row0 + t) * 2048 + 1952 + half * 8);
        float* ap = agl + t * 16 + half * 8;
        *(float4*)ap = make_float4(lo16(ua.x), hi16(ua.x), lo16(ua.y), hi16(ua.y));
        *(float4*)(ap + 4) = make_float4(lo16(ua.z), hi16(ua.z), lo16(ua.w), hi16(ua.w));
    }
    __syncthreads();
    {
        const int t = tid >> 2, kq = (tid & 3) * 8;
        const float* Wg = P.in[12] + (size_t)l * 16 * 128 + h * 32 + kq;
        const float* bg = P.in[13] + l * 128 + h * 32 + kq;
        float z[8];
#pragma unroll
        for (int q = 0; q < 8; ++q) z[q] = bg[q];
#pragma unroll
        for (int rr = 0; rr < 16; ++rr) {
            const float a = agl[t * 16 + rr];
#pragma unroll
            for (int q = 0; q < 8; ++q) z[q] += a * Wg[rr * 128 + q];
        }
#pragma unroll
        for (int q = 0; q < 8; ++q) {
            const float zz = z[q];
            const float ls = fminf(zz, 0.f) - LN2 * __builtin_amdgcn_logf(1.f + __builtin_amdgcn_exp2f(-fabsf(zz) * LOG2E));
            lb[t * 33 + kq + q] = ls * (1.f / 16.f);
        }
    }
    __syncthreads();
    if (tid < 32) { float b = 0.f; for (int t = 0; t < 64; ++t) { b += lb[t * 33 + tid]; lb[t * 33 + tid] = b; } }
    __syncthreads();
    float* glab = (float*)(P.ws + WS_GLAB) + (size_t)(l * 0 + j) * 2048;
    for (int e = tid; e < 2048; e += 256) { const int t = e >> 5, k = e & 31; glab[e] = lb[t * 33 + k]; }
    if (tid < 32) ((float*)(P.ws + WS_GDEC))[(size_t)j * 32 + tid] = __builtin_amdgcn_exp2f(lb[63 * 33 + tid] * LOG2E);
    {
        const int token = tid >> 2, part = tid & 3;
        const uint4 uk = *(const uint4*)(pb + (size_t)(row0 + token) * 2048 + 896 + h * 32 + part * 8);
        const int c0 = tid, c1 = tid + 256;
        const uint4 uv0 = *(const uint4*)(pb + (size_t)(row0 + (c0 >> 3)) * 2048 + 1024 + h * 64 + (c0 & 7) * 8);
        const uint4 uv1 = *(const uint4*)(pb + (size_t)(row0 + (c1 >> 3)) * 2048 + 1024 + h * 64 + (c1 & 7) * 8);
        const float kv[8] = {lo16(uk.x), hi16(uk.x), lo16(uk.y), hi16(uk.y), lo16(uk.z), hi16(uk.z), lo16(uk.w), hi16(uk.w)};
#pragma unroll
        for (int i = 0; i < 8; ++i) {
            const int k = part * 8 + i;
            kk[token * 33 + k] = kv[i] * __builtin_amdgcn_exp2f((lb[63 * 33 + k] - lb[token * 33 + k]) * LOG2E);
        }
        float* v0p = vv + (c0 >> 3) * 64 + (c0 & 7) * 8;
        *(float4*)v0p = make_float4(lo16(uv0.x), hi16(uv0.x), lo16(uv0.y), hi16(uv0.y));
        *(float4*)(v0p + 4) = make_float4(lo16(uv0.z), hi16(uv0.z), lo16(uv0.w), hi16(uv0.w));
        float* v1p = vv + (c1 >> 3) * 64 + (c1 & 7) * 8;
        *(float4*)v1p = make_float4(lo16(uv1.x), hi16(uv1.x), lo16(uv1.y), hi16(uv1.y));
        *(float4*)(v1p + 4) = make_float4(lo16(uv1.z), hi16(uv1.z), lo16(uv1.w), hi16(uv1.w));
    }
    __syncthreads();
    {
        const int k = tid >> 3, v8 = (tid & 7) * 8;
        float a[8];
#pragma unroll
        for (int q = 0; q < 8; ++q) a[q] = 0.f;
        for (int t = 0; t < 64; ++t) {
            const float kv = kk[t * 33 + k];
#pragma unroll
            for (int q = 0; q < 8; ++q) a[q] += kv * vv[t * 64 + v8 + q];
        }
        float* loc = (float*)(P.ws + WS_GLOC) + (size_t)j * 2048 + k * 64 + v8;
        *(float4*)loc = make_float4(a[0], a[1], a[2], a[3]);
        *(float4*)(loc + 4) = make_float4(a[4], a[5], a[6], a[7]);
    }
    __syncthreads();
}
DI void gla_stepB(const Params& P, const int l, const int sq) {
    const int tid = otid();
    const int e0 = tid * 8, k = e0 >> 6;
    float S[8];
    int j0, nch; float* so;
    if (sq < 16) {
        j0 = sq * 64; nch = 64;
#pragma unroll
        for (int q = 0; q < 8; ++q) S[q] = 0.f;
        so = P.out + O_GLA_P + ((size_t)l * 16 + sq) * 2048;
    } else {
        const int s = sq - 16; j0 = 1024 + s; nch = 1;
        const float* s0 = P.in[5] + ((size_t)l * 128 + s) * 2048 + e0;
        float4 a = *(const float4*)s0, b = *(const float4*)(s0 + 4);
        S[0] = a.x; S[1] = a.y; S[2] = a.z; S[3] = a.w; S[4] = b.x; S[5] = b.y; S[6] = b.z; S[7] = b.w;
        so = P.out + O_GLA_S + ((size_t)l * 128 + s) * 2048;
    }
    const float* __restrict__ loc = (const float*)(P.ws + WS_GLOC);
    const float* __restrict__ dec = (const float*)(P.ws + WS_GDEC);
    float* __restrict__ st = (float*)(P.ws + WS_GST);
    for (int c0 = 0; c0 < nch; c0 += 8) {
        float4 A[8], Bv[8]; float Dd[8];
#pragma unroll
        for (int u = 0; u < 8; ++u) {
            const size_t jj = (size_t)(j0 + (c0 + u < nch ? c0 + u : nch - 1));
            Dd[u] = dec[jj * 32 + k];
            A[u] = *(const float4*)(loc + jj * 2048 + e0);
            Bv[u] = *(const float4*)(loc + jj * 2048 + e0 + 4);
        }
#pragma unroll
        for (int u = 0; u < 8; ++u) {
            if (c0 + u < nch) {
                float* sp = st + (size_t)(j0 + c0 + u) * 2048 + e0;
                *(float4*)sp = make_float4(S[0], S[1], S[2], S[3]);
                *(float4*)(sp + 4) = make_float4(S[4], S[5], S[6], S[7]);
                const float d = Dd[u];
                S[0] = d * S[0] + A[u].x; S[1] = d * S[1] + A[u].y; S[2] = d * S[2] + A[u].z; S[3] = d * S[3] + A[u].w;
                S[4] = d * S[4] + Bv[u].x; S[5] = d * S[5] + Bv[u].y; S[6] = d * S[6] + Bv[u].z; S[7] = d * S[7] + Bv[u].w;
            }
        }
    }
    *(float4*)(so + e0) = make_float4(S[0], S[1], S[2], S[3]);
    *(float4*)(so + e0 + 4) = make_float4(S[4], S[5], S[6], S[7]);
}
DI void gla_stepC(const Params& P, const int l, const int j, unsigned char* smem) {
    float* qs = (float*)smem;
    float* ks = qs + 64 * 33;
    float* att = ks + 64 * 33;
    float* vs = att + 64 * 65;
    float* Ss = vs + 64 * 64;
    const int tid = otid();
    int row0, h; gla_job_rows(j, row0, h);
    const bf16_t* pb = (const bf16_t*)(P.ws + WS_PROJ);
    const float* glab = (const float*)(P.ws + WS_GLAB) + (size_t)j * 2048;
    const float scale = 0.17677669529663687f;
    {
        const int token = tid >> 2, part = tid & 3;
        const bf16_t* prow = pb + (size_t)(row0 + token) * 2048;
        const uint4 uq = *(const uint4*)(prow + 768 + h * 32 + part * 8);
        const uint4 uk = *(const uint4*)(prow + 896 + h * 32 + part * 8);
        const float4 b0 = *(const float4*)(glab + token * 32 + part * 8), b1 = *(const float4*)(glab + token * 32 + part * 8 + 4);
        const int c0 = tid, c1 = tid + 256;
        const uint4 uv0 = *(const uint4*)(pb + (size_t)(row0 + (c0 >> 3)) * 2048 + 1024 + h * 64 + (c0 & 7) * 8);
        const uint4 uv1 = *(const uint4*)(pb + (size_t)(row0 + (c1 >> 3)) * 2048 + 1024 + h * 64 + (c1 & 7) * 8);
        const float* st = (const float*)(P.ws + WS_GST) + (size_t)j * 2048;
        const float4 s0 = *(const float4*)(st + tid * 4), s1 = *(const float4*)(st + 1024 + tid * 4);
        const float qv[8] = {lo16(uq.x), hi16(uq.x), lo16(uq.y), hi16(uq.y), lo16(uq.z), hi16(uq.z), lo16(uq.w), hi16(uq.w)};
        const float kv[8] = {lo16(uk.x), hi16(uk.x), lo16(uk.y), hi16(uk.y), lo16(uk.z), hi16(uk.z), lo16(uk.w), hi16(uk.w)};
        const float bv[8] = {b0.x, b0.y, b0.z, b0.w, b1.x, b1.y, b1.z, b1.w};
#pragma unroll
        for (int i = 0; i < 8; ++i) {
            qs[token * 33 + part * 8 + i] = qv[i] * __builtin_amdgcn_exp2f(bv[i] * LOG2E) * scale;
            ks[token * 33 + part * 8 + i] = kv[i] * __builtin_amdgcn_exp2f(-bv[i] * LOG2E);
        }
        float* v0p = vs + (c0 >> 3) * 64 + (c0 & 7) * 8;
        *(float4*)v0p = make_float4(lo16(uv0.x), hi16(uv0.x), lo16(uv0.y), hi16(uv0.y));
        *(float4*)(v0p + 4) = make_float4(lo16(uv0.z), hi16(uv0.z), lo16(uv0.w), hi16(uv0.w));
        float* v1p = vs + (c1 >> 3) * 64 + (c1 & 7) * 8;
        *(float4*)v1p = make_float4(lo16(uv1.x), hi16(uv1.x), lo16(uv1.y), hi16(uv1.y));
        *(float4*)(v1p + 4) = make_float4(lo16(uv1.z), hi16(uv1.z), lo16(uv1.w), hi16(uv1.w));
        *(float4*)(Ss + tid * 4) = s0;
        *(float4*)(Ss + 1024 + tid * 4) = s1;
    }
    __syncthreads();
    const int ty = tid >> 4, tx = tid & 15;
    {
        float a[4][4];
#pragma unroll
        for (int i = 0; i < 4; ++i)
#pragma unroll
            for (int q = 0; q < 4; ++q) a[i][q] = 0.f;
#pragma unroll 4
        for (int k = 0; k < 32; ++k) {
            float qv[4], kv[4];
#pragma unroll
            for (int i = 0; i < 4; ++i) { qv[i] = qs[(4 * ty + i) * 33 + k]; kv[i] = ks[(4 * tx + i) * 33 + k]; }
#pragma unroll
            for (int i = 0; i < 4; ++i)
#pragma unroll
                for (int q = 0; q < 4; ++q) a[i][q] += qv[i] * kv[q];
        }
#pragma unroll
        for (int i = 0; i < 4; ++i)
#pragma unroll
            for (int q = 0; q < 4; ++q) { const int t = 4 * ty + i, s = 4 * tx + q; att[t * 65 + s] = (s <= t) ? a[i][q] : 0.f; }
    }
    __syncthreads();
    {
        float o[4][4];
#pragma unroll
        for (int i = 0; i < 4; ++i)
#pragma unroll
            for (int q = 0; q < 4; ++q) o[i][q] = 0.f;
#pragma unroll 4
        for (int k = 0; k < 32; ++k) {
            float qv[4];
#pragma unroll
            for (int i = 0; i < 4; ++i) qv[i] = qs[(4 * ty + i) * 33 + k];
            const float4 sv = *(const float4*)(Ss + k * 64 + 4 * tx);
#pragma unroll
            for (int i = 0; i < 4; ++i) { o[i][0] += qv[i] * sv.x; o[i][1] += qv[i] * sv.y; o[i][2] += qv[i] * sv.z; o[i][3] += qv[i] * sv.w; }
        }
#pragma unroll 4
        for (int s = 0; s < 64; ++s) {
            float av[4];
#pragma unroll
            for (int i = 0; i < 4; ++i) av[i] = att[(4 * ty + i) * 65 + s];
            const float4 sv = *(const float4*)(vs + s * 64 + 4 * tx);
#pragma unroll
            for (int i = 0; i < 4; ++i) { o[i][0] += av[i] * sv.x; o[i][1] += av[i] * sv.y; o[i][2] += av[i] * sv.z; o[i][3] += av[i] * sv.w; }
        }
        const float4 gg = *(const float4*)(P.in[14] + l * 64 + 4 * tx);
        bf16_t* mix = (bf16_t*)(P.ws + WS_MIX);
        uint2 rgu[4];
#pragma unroll
        for (int i = 0; i < 4; ++i) rgu[i] = *(const uint2*)(pb + (size_t)(row0 + 4 * ty + i) * 2048 + 1280 + h * 64 + 4 * tx);
#pragma unroll
        for (int i = 0; i < 4; ++i) {
            float ss = o[i][0] * o[i][0] + o[i][1] * o[i][1] + o[i][2] * o[i][2] + o[i][3] * o[i][3];
            ss += __shfl_xor(ss, 1); ss += __shfl_xor(ss, 2); ss += __shfl_xor(ss, 4); ss += __shfl_xor(ss, 8);
            const float ri = __builtin_amdgcn_rsqf(ss * (1.f / 64.f) + EPS);
            const size_t row = (size_t)(row0 + 4 * ty + i);
            const uint2 ru = rgu[i];
            const float r0 = lo16(ru.x), r1 = hi16(ru.x), r2 = lo16(ru.y), r3 = hi16(ru.y);
            uint2 b; b.x = pack2(o[i][0] * ri * gg.x * silu(r0), o[i][1] * ri * gg.y * silu(r1));
            b.y = pack2(o[i][2] * ri * gg.z * silu(r2), o[i][3] * ri * gg.w * silu(r3));
            *(uint2*)(mix + row * 1024 + 256 + h * 64 + 4 * tx) = b;
        }
    }
    __syncthreads();
}

struct AttnJob {
    const bf16_t* q0; int q0s; const bf16_t* q1; int q1s;
    int NT, npast, diag;
    const bf16_t* kn0; int kn0s; const bf16_t* kn1; int kn1s; const bf16_t* vn; int vns;
    const bf16_t* kp0; int kp0s; const bf16_t* kp1; int kp1s; const bf16_t* vp; int vps;
    const float* knf; const float* vnf; const float* kpf; const float* vpf; int pfs;
    bf16_t* out; int outs; const float* gain;
};

template <int HD0, int HD1, int DV, bool F32OK, int NTH, int NKR, int NVR>
DI void attn_issue_tile(const AttnJob& J, const int kt, u32x4 (&tk)[NKR], u32x4 (&tv)[NVR], const int p) {
    constexpr int CK = (HD0 + HD1) / 8, CV = DV / 8, NK = 64 * CK / NTH, NV = 64 * CV / NTH;
    const bool past = kt < J.npast;
    const int key0 = past ? kt * 64 : (kt - J.npast) * 64;
    if constexpr (F32OK) {
        const float* kb = past ? J.kpf : J.knf;
        const float* vb = past ? J.vpf : J.vnf;
#pragma unroll
        for (int i = 0; i < NK; ++i) {
            const int c = p + NTH * i, key = c / CK, part = c % CK;
            const float* s = kb + (size_t)(key0 + key) * J.pfs + part * 8;
            tk[2 * i] = gload16_async_nt(s); tk[2 * i + 1] = gload16_async_nt(s + 4);
        }
#pragma unroll
        for (int i = 0; i < NV; ++i) {
            const int c = p + NTH * i, key = c / CV, part = c % CV;
            const float* s = vb + (size_t)(key0 + key) * J.pfs + part * 8;
            tv[2 * i] = gload16_async_nt(s); tv[2 * i + 1] = gload16_async_nt(s + 4);
        }
    } else {
        const bf16_t* k0 = past ? J.kp0 : J.kn0; const int k0s = past ? J.kp0s : J.kn0s;
        const bf16_t* k1 = past ? J.kp1 : J.kn1; const int k1s = past ? J.kp1s : J.kn1s;
        const bf16_t* vsrc = past ? J.vp : J.vn; const int vss = past ? J.vps : J.vns;
#pragma unroll
        for (int i = 0; i < NK; ++i) {
            const int c = p + NTH * i, key = c / CK, part = c % CK;
            const bf16_t* s;
            if (HD1 == 0 || part < HD0 / 8) s = k0 + (size_t)(key0 + key) * k0s + part * 8;
            else s = k1 + (size_t)(key0 + key) * k1s + (part - HD0 / 8) * 8;
            tk[i] = gload16_async(s);
        }
#pragma unroll
        for (int i = 0; i < NV; ++i) {
            const int c = p + NTH * i, key = c / CV, part = c % CV;
            tv[i] = gload16_async(vsrc + (size_t)(key0 + key) * vss + part * 8);
        }
    }
}
DI u32x4 cvt8r(const u32x4 a, const u32x4 b) {
    u32x4 r;
    r.x = pack2(__uint_as_float(a.x), __uint_as_float(a.y)); r.y = pack2(__uint_as_float(a.z), __uint_as_float(a.w));
    r.z = pack2(__uint_as_float(b.x), __uint_as_float(b.y)); r.w = pack2(__uint_as_float(b.z), __uint_as_float(b.w));
    return r;
}
DI void vt_scatter(bf16_t* vt, const u32x4 u) {
    vt[0] = u.x & 0xffff; vt[68] = u.x >> 16; vt[136] = u.y & 0xffff; vt[204] = u.y >> 16;
    vt[272] = u.z & 0xffff; vt[340] = u.z >> 16; vt[408] = u.w & 0xffff; vt[476] = u.w >> 16;
}
template <int HD0, int HD1, int DV, bool F32OK, int NTH, int NKR, int NVR>
DI void attn_store_tile(const AttnJob& J, const int kt, const u32x4 (&tk)[NKR], const u32x4 (&tv)[NVR], unsigned char* Ks, unsigned char* Vt, const int p) {
    constexpr int HD = HD0 + HD1, CK = HD / 8, CV = DV / 8, KSTR = (HD + 8) * 2, NK = 64 * CK / NTH, NV = 64 * CV / NTH;
#pragma unroll
    for (int i = 0; i < NK; ++i) {
        const int c = p + NTH * i, key = c / CK, part = c % CK;
        u32x4 u;
        if constexpr (F32OK) u = cvt8r(tk[2 * i], tk[2 * i + 1]); else u = tk[i];
        *(u32x4*)(Ks + key * KSTR + part * 16) = u;
    }
#pragma unroll
    for (int i = 0; i < NV; ++i) {
        const int c = p + NTH * i, key = c / CV, part = c % CV;
        u32x4 u;
        if constexpr (F32OK) u = cvt8r(tv[2 * i], tv[2 * i + 1]); else u = tv[i];
        *(u32x4*)(Vt + key * (DV * 2 + 16) + part * 16) = u;
    }
}

template <int MODE, int HD0, int HD1, int DV, bool F32OK, bool PF>
DI void attn_job(const AttnJob& J, unsigned char* smem) {
    constexpr int HD = HD0 + HD1, NKS = HD / 16, NDT = DV / 32, KSTR = (HD + 8) * 2;
    constexpr int VSTR = DV * 2 + 16;
    constexpr int KBYTES = 64 * KSTR, VBYTES = 64 * VSTR, PAIRB = KBYTES + VBYTES;
    const int tid = otid(), lane = tid & 63, wave = tid >> 6, r = lane & 31, h = lane >> 5;
    const int qh = wave & 1, kh = wave >> 1, p = tid & 127;
    unsigned char* Ks = smem + kh * PAIRB;
    unsigned char* Vt = Ks + KBYTES;
    const int NT = J.NT, n0 = (NT + 1) >> 1, n1 = NT - n0;
    constexpr int NKR = (64 * (HD / 8) / 128) * (F32OK ? 2 : 1), NVR = (64 * (DV / 8) / 128) * (F32OK ? 2 : 1);
    u32x4 tk[NKR], tv[NVR];
    {
        const int kt0 = kh == 0 ? NT - 1 : n1 - 1;
        if (PF && kt0 >= 0) attn_issue_tile<HD0, HD1, DV, F32OK, 128>(J, kt0, tk, tv, p);
    }
    bf16x8 qf[NKS];
#pragma unroll
    for (int ks = 0; ks < NKS; ++ks) {
        if (16 * ks < HD0) qf[ks] = *(const bf16x8*)(J.q0 + (size_t)(32 * qh + r) * J.q0s + 16 * ks + 8 * h);
        else qf[ks] = *(const bf16x8*)(J.q1 + (size_t)(32 * qh + r) * J.q1s + (16 * ks - HD0) + 8 * h);
    }
    f32x16 oT[NDT];
#pragma unroll
    for (int dt = 0; dt < NDT; ++dt)
#pragma unroll
        for (int i = 0; i < 16; ++i) oT[dt][i] = 0.f;
    float m_run = -1e30f, l_run = 0.f, R = (MODE == 1) ? 1.f : 0.f;
    for (int it = 0; it < n0; ++it) {
        const int kt = kh == 0 ? NT - 1 - it : n1 - 1 - it;
        const bool active = kt >= 0;
        if (!PF && active) attn_issue_tile<HD0, HD1, DV, F32OK, 128>(J, kt, tk, tv, p);
        wait_vm0();
        __syncthreads();
        if (active) attn_store_tile<HD0, HD1, DV, F32OK, 128>(J, kt, tk, tv, Ks, Vt, p);
        __syncthreads();
        if (PF && it + 1 < n0 && kt - 1 >= 0) attn_issue_tile<HD0, HD1, DV, F32OK, 128>(J, kt - 1, tk, tv, p);
        if (!active) continue;
        f32x16 sT[2];
#pragma unroll
        for (int mt = 0; mt < 2; ++mt) {
#pragma unroll
            for (int i = 0; i < 16; ++i) sT[mt][i] = 0.f;
#pragma unroll
            for (int ks = 0; ks < NKS; ++ks) {
                const bf16x8 a = *(const bf16x8*)(Ks + (32 * mt + r) * KSTR + (16 * ks + 8 * h) * 2);
                sT[mt] = MFMA32(a, qf[ks], sT[mt]);
            }
        }
        if (MODE == 0) {
            float mx = sT[0][0];
#pragma unroll
            for (int mt = 0; mt < 2; ++mt)
#pragma unroll
                for (int i = 0; i < 16; ++i) mx = fmaxf(mx, sT[mt][i]);
            mx = fmaxf(mx, __shfl_xor(mx, 32));
            const float m_new = fmaxf(m_run, mx);
            const float alpha = __builtin_amdgcn_exp2f(m_run - m_new);
            m_run = m_new;
            float ps = 0.f;
#pragma unroll
            for (int mt = 0; mt < 2; ++mt)
#pragma unroll
                for (int i = 0; i < 16; ++i) { const float pv = __builtin_amdgcn_exp2f(sT[mt][i] - m_new); sT[mt][i] = pv; ps += pv; }
            l_run = l_run * alpha + ps;
#pragma unroll
            for (int dt = 0; dt < NDT; ++dt)
#pragma unroll
                for (int i = 0; i < 16; ++i) oT[dt][i] *= alpha;
        } else {
            const bool dg = J.diag && (kt == NT - 1);
            const int qi = 32 * qh + r;
            float kp[2][16];
#pragma unroll
            for (int mt = 0; mt < 2; ++mt)
#pragma unroll
                for (int i = 0; i < 16; ++i) {
                    const float t = fminf(sT[mt][i] * (-0.125f * LOG2E), 115.f);
                    const float e = __builtin_amdgcn_exp2f(t);
                    const float sg = __builtin_amdgcn_rcpf(1.f + e);
                    const bool masked = dg && (32 * mt + crow(i, h) >= qi);
                    sT[mt][i] = masked ? 0.f : sg;
                    kp[mt][i] = masked ? 1.f : e * sg;
                }
            float G[2][4], Go[2][4];
#pragma unroll
            for (int mt = 0; mt < 2; ++mt)
#pragma unroll
                for (int g = 0; g < 4; ++g) {
                    G[mt][g] = (kp[mt][4 * g] * kp[mt][4 * g + 1]) * (kp[mt][4 * g + 2] * kp[mt][4 * g + 3]);
                    Go[mt][g] = __shfl_xor(G[mt][g], 32);
                }
            float run = R;
#pragma unroll
            for (int mt = 1; mt >= 0; --mt)
#pragma unroll
                for (int g = 3; g >= 0; --g) {
                    const float after = h ? run : run * Go[mt][g];
                    const float p3 = after, p2 = p3 * kp[mt][4 * g + 3], p1 = p2 * kp[mt][4 * g + 2], p0 = p1 * kp[mt][4 * g + 1];
                    sT[mt][4 * g + 3] *= p3;
                    sT[mt][4 * g + 2] *= p2;
                    sT[mt][4 * g + 1] *= p1;
                    sT[mt][4 * g + 0] *= p0;
                    run *= G[mt][g] * Go[mt][g];
                }
            R = run;
        }
#pragma unroll
        for (int mt = 0; mt < 2; ++mt)
#pragma unroll
            for (int s = 0; s < 2; ++s) {
                uint4 pu;
                pu.x = pack2(sT[mt][8 * s], sT[mt][8 * s + 1]); pu.y = pack2(sT[mt][8 * s + 2], sT[mt][8 * s + 3]);
                pu.z = pack2(sT[mt][8 * s + 4], sT[mt][8 * s + 5]); pu.w = pack2(sT[mt][8 * s + 6], sT[mt][8 * s + 7]);
                const bf16x8 pf = __builtin_bit_cast(bf16x8, pu);
#pragma unroll
                for (int dt = 0; dt < NDT; ++dt) {
                    const unsigned char* vp = Vt + (32 * mt + 16 * s + 4 * h + ((lane & 15) >> 2)) * VSTR + dt * 64 + ((lane >> 4) & 1) * 32 + (lane & 3) * 8;
                    const s16x4 a0 = __builtin_amdgcn_ds_read_tr16_b64_v4i16((LAS s16x4*)vp);
                    const s16x4 a1 = __builtin_amdgcn_ds_read_tr16_b64_v4i16((LAS s16x4*)(vp + 8 * VSTR));
                    const bf16x8 av = __builtin_shufflevector(a0, a1, 0, 1, 2, 3, 4, 5, 6, 7);
                    oT[dt] = MFMA32(av, pf, oT[dt]);
                }
            }
    }
    __syncthreads();
    float* X = (float*)smem + (size_t)qh * (NDT * 16 + 2) * 64;
    if (kh == 1) {
#pragma unroll
        for (int dt = 0; dt < NDT; ++dt)
#pragma unroll
            for (int i = 0; i < 16; ++i) X[(dt * 16 + i) * 64 + lane] = oT[dt][i];
        X[(NDT * 16) * 64 + lane] = MODE == 0 ? m_run : R;
        X[(NDT * 16 + 1) * 64 + lane] = l_run;
    }
    __syncthreads();
    if (kh == 0) {
        if (MODE == 0) {
            const float m1 = X[(NDT * 16) * 64 + lane], l1 = X[(NDT * 16 + 1) * 64 + lane];
            const float m = fmaxf(m_run, m1);
            const float a0 = __builtin_amdgcn_exp2f(m_run - m), a1 = __builtin_amdgcn_exp2f(m1 - m);
            float lt = l_run * a0 + l1 * a1;
            lt += __shfl_xor(lt, 32);
            const float inv = __builtin_amdgcn_rcpf(lt);
#pragma unroll
            for (int dt = 0; dt < NDT; ++dt)
#pragma unroll
                for (int i = 0; i < 16; ++i) oT[dt][i] = (oT[dt][i] * a0 + X[(dt * 16 + i) * 64 + lane] * a1) * inv;
        } else {
            const float f = R;
#pragma unroll
            for (int dt = 0; dt < NDT; ++dt)
#pragma unroll
                for (int i = 0; i < 16; ++i) oT[dt][i] += f * X[(dt * 16 + i) * 64 + lane];
        }
        float ri = 1.f;
        if (J.gain) {
            float ss = 0.f;
#pragma unroll
            for (int dt = 0; dt < NDT; ++dt)
#pragma unroll
                for (int i = 0; i < 16; ++i) ss += oT[dt][i] * oT[dt][i];
            ss += __shfl_xor(ss, 32);
            ri = __builtin_amdgcn_rsqf(ss * (1.f / DV) + EPS);
        }
        bf16_t* orow = J.out + (size_t)(32 * qh + r) * J.outs;
        float4 ggv[NDT][4];
#pragma unroll
        for (int dt = 0; dt < NDT; ++dt)
#pragma unroll
            for (int g = 0; g < 4; ++g) ggv[dt][g] = J.gain ? *(const float4*)(J.gain + 32 * dt + 8 * g + 4 * h) : make_float4(1.f, 1.f, 1.f, 1.f);
#pragma unroll
        for (int dt = 0; dt < NDT; ++dt)
#pragma unroll
            for (int g = 0; g < 4; ++g) {
                const int d = 32 * dt + 8 * g + 4 * h;
                const float4 gg = ggv[dt][g];
                uint2 b; b.x = pack2(oT[dt][4 * g] * ri * gg.x, oT[dt][4 * g + 1] * ri * gg.y); b.y = pack2(oT[dt][4 * g + 2] * ri * gg.z, oT[dt][4 * g + 3] * ri * gg.w);
                *(uint2*)(orow + d) = b;
            }
    }
    __syncthreads();
}

template <int MODE, int HD0, int HD1, int DV>
DI void attn_job128(const AttnJob& J, const int qt2, unsigned char* smem) {
    constexpr int HD = HD0 + HD1, NKS = HD / 16, NDT = DV / 32, KSTR = (HD + 8) * 2, VSTR = DV * 2 + 16;
    constexpr int KBYTES = 64 * KSTR, VBYTES = 64 * VSTR, BUFB = KBYTES + VBYTES;
    const int tid = otid(), lane = tid & 63, wave = tid >> 6, r = lane & 31, h = lane >> 5;
    const int my_last = 2 * qt2 + (wave >> 1);
    const int NT = 2 * qt2 + 2;
    constexpr int NKR = 64 * (HD / 8) / 256, NVR = 64 * (DV / 8) / 256;
    u32x4 tk[NKR], tv[NVR];
    attn_issue_tile<HD0, HD1, DV, false, 256>(J, NT - 1, tk, tv, tid);
    bf16x8 qf[NKS];
#pragma unroll
    for (int ks = 0; ks < NKS; ++ks) {
        if (16 * ks < HD0) qf[ks] = *(const bf16x8*)(J.q0 + (size_t)(32 * wave + r) * J.q0s + 16 * ks + 8 * h);
        else qf[ks] = *(const bf16x8*)(J.q1 + (size_t)(32 * wave + r) * J.q1s + (16 * ks - HD0) + 8 * h);
    }
    f32x16 oT[NDT];
#pragma unroll
    for (int dt = 0; dt < NDT; ++dt)
#pragma unroll
        for (int i = 0; i < 16; ++i) oT[dt][i] = 0.f;
    float m_run = -1e30f, l_run = 0.f, R = (MODE == 1) ? 1.f : 0.f;
    for (int it = 0; it < NT; ++it) {
        const int kt = NT - 1 - it;
        unsigned char* Ks = smem + (it & 1) * BUFB;
        unsigned char* Vt = Ks + KBYTES;
        wait_vm0();
        attn_store_tile<HD0, HD1, DV, false, 256>(J, kt, tk, tv, Ks, Vt, tid);
        __syncthreads();
        if (it + 1 < NT) attn_issue_tile<HD0, HD1, DV, false, 256>(J, kt - 1, tk, tv, tid);
        if (kt > my_last) continue;
        f32x16 sT[2];
#pragma unroll
        for (int mt = 0; mt < 2; ++mt) {
#pragma unroll
            for (int i = 0; i < 16; ++i) sT[mt][i] = 0.f;
#pragma unroll
            for (int ks = 0; ks < NKS; ++ks) {
                const bf16x8 a = *(const bf16x8*)(Ks + (32 * mt + r) * KSTR + (16 * ks + 8 * h) * 2);
                sT[mt] = MFMA32(a, qf[ks], sT[mt]);
            }
        }
        if (MODE == 0) {
            float mx = sT[0][0];
#pragma unroll
            for (int mt = 0; mt < 2; ++mt)
#pragma unroll
                for (int i = 0; i < 16; ++i) mx = fmaxf(mx, sT[mt][i]);
            mx = fmaxf(mx, __shfl_xor(mx, 32));
            const float m_new = fmaxf(m_run, mx);
            const float alpha = __builtin_amdgcn_exp2f(m_run - m_new);
            m_run = m_new;
            float ps = 0.f;
#pragma unroll
            for (int mt = 0; mt < 2; ++mt)
#pragma unroll
                for (int i = 0; i < 16; ++i) { const float pv = __builtin_amdgcn_exp2f(sT[mt][i] - m_new); sT[mt][i] = pv; ps += pv; }
            l_run = l_run * alpha + ps;
#pragma unroll
            for (int dt = 0; dt < NDT; ++dt)
#pragma unroll
                for (int i = 0; i < 16; ++i) oT[dt][i] *= alpha;
        } else {
            const bool dg = (kt == my_last);
            const int qi = 32 * (wave & 1) + r;
            float kp[2][16];
#pragma unroll
            for (int mt = 0; mt < 2; ++mt)
#pragma unroll
                for (int i = 0; i < 16; ++i) {
                    const float t = fminf(sT[mt][i] * (-0.125f * LOG2E), 115.f);
                    const float e = __builtin_amdgcn_exp2f(t);
                    const float sg = __builtin_amdgcn_rcpf(1.f + e);
                    const bool masked = dg && (32 * mt + crow(i, h) >= qi);
                    sT[mt][i] = masked ? 0.f : sg;
                    kp[mt][i] = masked ? 1.f : e * sg;
                }
            float G[2][4], Go[2][4];
#pragma unroll
            for (int mt = 0; mt < 2; ++mt)
#pragma unroll
                for (int g = 0; g < 4; ++g) {
                    G[mt][g] = (kp[mt][4 * g] * kp[mt][4 * g + 1]) * (kp[mt][4 * g + 2] * kp[mt][4 * g + 3]);
                    Go[mt][g] = __shfl_xor(G[mt][g], 32);
                }
            float run = R;
#pragma unroll
            for (int mt = 1; mt >= 0; --mt)
#pragma unroll
                for (int g = 3; g >= 0; --g) {
                    const float after = h ? run : run * Go[mt][g];
                    const float p3 = after, p2 = p3 * kp[mt][4 * g + 3], p1 = p2 * kp[mt][4 * g + 2], p0 = p1 * kp[mt][4 * g + 1];
                    sT[mt][4 * g + 3] *= p3;
                    sT[mt][4 * g + 2] *= p2;
                    sT[mt][4 * g + 1] *= p1;
                    sT[mt][4 * g + 0] *= p0;
                    run *= G[mt][g] * Go[mt][g];
                }
            R = run;
        }
#pragma unroll
        for (int mt = 0; mt < 2; ++mt)
#pragma unroll
            for (int s = 0; s < 2; ++s) {
                uint4 pu;
                pu.x = pack2(sT[mt][8 * s], sT[mt][8 * s + 1]); pu.y = pack2(sT[mt][8 * s + 2], sT[mt][8 * s + 3]);
                pu.z = pack2(sT[mt][8 * s + 4], sT[mt][8 * s + 5]); pu.w = pack2(sT[mt][8 * s + 6], sT[mt][8 * s + 7]);
                const bf16x8 pf = __builtin_bit_cast(bf16x8, pu);
#pragma unroll
                for (int dt = 0; dt < NDT; ++dt) {
                    const unsigned char* vp = Vt + (32 * mt + 16 * s + 4 * h + ((lane & 15) >> 2)) * VSTR + dt * 64 + ((lane >> 4) & 1) * 32 + (lane & 3) * 8;
                    const s16x4 a0 = __builtin_amdgcn_ds_read_tr16_b64_v4i16((LAS s16x4*)vp);
                    const s16x4 a1 = __builtin_amdgcn_ds_read_tr16_b64_v4i16((LAS s16x4*)(vp + 8 * VSTR));
                    const bf16x8 av = __builtin_shufflevector(a0, a1, 0, 1, 2, 3, 4, 5, 6, 7);
                    oT[dt] = MFMA32(av, pf, oT[dt]);
                }
            }
    }
    {
        float inv = 1.f;
        if (MODE == 0) { float lt = l_run + __shfl_xor(l_run, 32); inv = __builtin_amdgcn_rcpf(lt); }
        float ss = 0.f;
#pragma unroll
        for (int dt = 0; dt < NDT; ++dt)
#pragma unroll
            for (int i = 0; i < 16; ++i) { oT[dt][i] *= inv; ss += oT[dt][i] * oT[dt][i]; }
        ss += __shfl_xor(ss, 32);
        const float ri = __builtin_amdgcn_rsqf(ss * (1.f / DV) + EPS);
        bf16_t* orow = J.out + (size_t)(32 * wave + r) * J.outs;
        float4 ggv[NDT][4];
#pragma unroll
        for (int dt = 0; dt < NDT; ++dt)
#pragma unroll
            for (int g = 0; g < 4; ++g) ggv[dt][g] = *(const float4*)(J.gain + 32 * dt + 8 * g + 4 * h);
#pragma unroll
        for (int dt = 0; dt < NDT; ++dt)
#pragma unroll
            for (int g = 0; g < 4; ++g) {
                const int d = 32 * dt + 8 * g + 4 * h;
                const float4 gg = ggv[dt][g];
                uint2 b; b.x = pack2(oT[dt][4 * g] * ri * gg.x, oT[dt][4 * g + 1] * ri * gg.y); b.y = pack2(oT[dt][4 * g + 2] * ri * gg.z, oT[dt][4 * g + 3] * ri * gg.w);
                *(uint2*)(orow + d) = b;
            }
    }
    __syncthreads();
}

DI void mixer_job(const Params& P, const int l, const int j, unsigned char* smem) {
    const bf16_t* pb = (const bf16_t*)(P.ws + WS_PROJ);
    bf16_t* mix = (bf16_t*)(P.ws + WS_MIX);
    if (j >= 1920) { gla_stepC(P, l, j - 1920, smem); return; }
    AttnJob J;
    J.q1 = nullptr; J.q1s = 0; J.kn1 = nullptr; J.kn1s = 0; J.kp0 = nullptr; J.kp0s = 0; J.kp1 = nullptr; J.kp1s = 0; J.vp = nullptr; J.vps = 0;
    J.kpf = nullptr; J.vpf = nullptr; J.knf = nullptr; J.vnf = nullptr; J.pfs = 0; J.npast = 0; J.diag = 0; J.NT = 0;
    bool sb; int b, h, qt; bool sample;
    int s_idx = -1, level = 0, w = 0;
    if (j < 1152) { level = j / 72; const int w72 = j - level * 72; if (w72 < 24) s_idx = level * 24 + w72; else w = w72 - 24; }
    else { const int jj = j - 1152; level = 16 + jj / 48; w = jj % 48; }
    if (s_idx >= 0) {
        sample = true; qt = 0;
        if (s_idx < 128) { sb = true; b = s_idx >> 2; h = s_idx & 3; }
        else { const int ss = s_idx - 128; sb = false; b = ss >> 3; h = ss & 7; }
    } else {
        sample = false; qt = 2 * (31 - level);
        if (w < 32) { sb = false; b = w >> 3; h = w & 7; } else { sb = true; b = (w - 32) >> 2; h = (w - 32) & 3; }
    }
    const size_t seq0 = sample ? (size_t)R_P + b * 64 : (size_t)b * 4096;
    const size_t qrow = seq0 + (size_t)qt * 64;
    if (sb) {
        J.q0 = pb + qrow * 2048 + h * 64; J.q0s = 2048;
        J.kn0 = pb + seq0 * 2048 + 256 + h * 64; J.kn0s = 2048;
        J.vn = pb + seq0 * 2048 + 512 + h * 64; J.vns = 2048;
        J.diag = 1;
        J.out = mix + qrow * 1024 + h * 64; J.outs = 1024; J.gain = P.in[15] + l * 64;
        if (sample) {
            J.NT = 65; J.npast = 64;
            J.kpf = P.in[3] + ((((size_t)l * 32 + b) * 4096) * 4 + h) * 64;
            J.vpf = P.in[4] + ((((size_t)l * 32 + b) * 4096) * 4 + h) * 64;
            J.knf = P.out + O_SBK_S + (((size_t)l * 32 + b) * 64) * 256 + h * 64;
            J.vnf = P.out + O_SBV_S + (((size_t)l * 32 + b) * 64) * 256 + h * 64;
            J.pfs = 256;
            attn_job<1, 64, 0, 64, true, SB_PF>(J, smem);
        } else {
            attn_job128<1, 64, 0, 64>(J, qt >> 1, smem);
        }
    } else {
        J.q0 = (const bf16_t*)(P.ws + WS_QN) + qrow * 512 + h * 64; J.q0s = 512;
        J.q1 = (const bf16_t*)(P.ws + WS_QR) + qrow * 256 + h * 32; J.q1s = 256;
        J.kn0 = (const bf16_t*)(P.ws + WS_KNB) + seq0 * 512 + h * 64; J.kn0s = 512;
        J.kn1 = (const bf16_t*)(P.ws + WS_KRB) + seq0 * 32; J.kn1s = 32;
        J.vn = (const bf16_t*)(P.ws + WS_VB) + seq0 * 512 + h * 64; J.vns = 512;
        if (sample) {
            J.NT = 65; J.npast = 64;
            J.kp0 = (const bf16_t*)(P.ws + WS_KNP) + ((size_t)b * 4096) * 512 + h * 64; J.kp0s = 512;
            J.kp1 = (const bf16_t*)(P.ws + WS_KRP) + ((size_t)l * NPAST + (size_t)b * 4096) * 32; J.kp1s = 32;
            J.vp = (const bf16_t*)(P.ws + WS_VP) + ((size_t)b * 4096) * 512 + h * 64; J.vps = 512;
        }
        J.out = mix + qrow * 1024 + 512 + h * 64; J.outs = 1024; J.gain = P.in[24] + l * 64;
        if (sample) attn_job<0, 64, 32, 64, false, true>(J, smem);
        else attn_job128<0, 64, 32, 64>(J, qt >> 1, smem);
    }
}
DI void cross_job(const Params& P, const int l, const int j, unsigned char* smem) {
    AttnJob J;
    J.q1 = nullptr; J.q1s = 0; J.kn1 = nullptr; J.kn1s = 0; J.kp0 = nullptr; J.kp0s = 0; J.kp1 = nullptr; J.kp1s = 0; J.vp = nullptr; J.vps = 0;
    J.kpf = nullptr; J.vpf = nullptr; J.knf = nullptr; J.vnf = nullptr; J.pfs = 0; J.npast = 0; J.diag = 0; J.NT = 4; J.gain = nullptr;
    size_t qrow; int h;
    if (j < 1024) {
        const int qt = j & 63, b = j >> 8; h = (j >> 6) & 3;
        qrow = (size_t)b * 4096 + qt * 64;
        J.kn0 = (const bf16_t*)(P.ws + WS_MEMKP) + ((size_t)l * 1024 + b * 256) * 512 + h * 128;
        J.vn = (const bf16_t*)(P.ws + WS_MEMVP) + ((size_t)l * 1024 + b * 256) * 512 + h * 128;
    } else {
        const int s = j - 1024, b = s >> 2; h = s & 3;
        qrow = (size_t)R_P + b * 64;
        J.kn0 = (const bf16_t*)(P.ws + WS_MEMKS) + (((size_t)l * 32 + b) * 256) * 512 + h * 128;
        J.vn = (const bf16_t*)(P.ws + WS_MEMVS) + (((size_t)l * 32 + b) * 256) * 512 + h * 128;
    }
    J.kn0s = 512; J.vns = 512;
    J.q0 = (const bf16_t*)(P.ws + WS_QC) + qrow * 512 + h * 128; J.q0s = 512;
    J.out = (bf16_t*)(P.ws + WS_OC) + qrow * 512 + h * 128; J.outs = 512;
    attn_job<0, 128, 0, 128, false, CR_PF>(J, smem);
}

#define FOR_DYN(q, total, ci) for (int q = dyn_next((unsigned*)(P.ws + WS_CNT) + (ci)); q < (total); q = dyn_next((unsigned*)(P.ws + WS_CNT) + (ci)))
DI int dyn_next(unsigned* cnt) {
    __shared__ int sjob;
    __syncthreads();
    if (threadIdx.x == 0) sjob = (int)atomicAdd(cnt, 1u);
    __syncthreads();
    return sjob;
}
#define FOR_XJOBS(q, total) for (int it_ = 0, q; (q = ((it_ * 8 + (B & 7)) * (G >> 3)) + (B >> 3)) < (total); ++it_)
DI void run_phase(const Params& P, const int ph, unsigned char* smem, const int rep = 0) {
    const int G = gridDim.x, B = blockIdx.x;
    int tm, tn;
    const bf16_t* W = (const bf16_t*)(P.ws + WS_W);
    if (ph == 0) {
        for (int j = B; j < 18976; j += G) {
            if (j < 6944) prep_weight_tile(P, j, smem);
            else if (j < 11552) prep_x_rows(P, j - 6944);
            else if (j < 11808) prep_mem_rows(P, j - 11552);
            else prep_convert(P, j - 11808);
        }
        return;
    }
    const int l = (ph - 1) / 10, s = (ph - 1) % 10;
    const bf16_t* Wl = W + (size_t)l * W_LAYER;
    if (s == 0) {
        const int extra = (l == 0) ? 128 : 0;
        FOR_XJOBS(j, 2304 + extra) {
            if (j < 2304) { tile_map(j, 16, tm, tn); gemm_tile16<E_PROJ, 2>(P, l, (const bf16_t*)(P.ws + WS_XB), 1024, Wl + W_IN, 1024, tm, tn, smem); }
            else {
                const int jj = j - 2304, ll = jj >> 6, t = jj & 63;
                const bf16_t* Wll = W + (size_t)ll * W_LAYER;
                if (t < 32) gemm_tile<E_MEMK>(P, ll, (const bf16_t*)(P.ws + WS_MEMB), 1024, Wll + W_CK, 1024, t >> 2, t & 3, smem, 0);
                else gemm_tile<E_MEMV>(P, ll, (const bf16_t*)(P.ws + WS_MEMB), 1024, Wll + W_CV, 1024, (t - 32) >> 2, t & 3, smem, 0);
            }
        }
    } else if (s == 1) {
        FOR_XJOBS(j, 1152 + 4608) {
            if (j < 1152) gla_stepA(P, l, j, smem);
            else rowpass(P, l, j - 1152);
        }
        kv_stream(P, l, (const bf16_t*)(P.ws + WS_LATP) + (size_t)l * NPAST * 128, Wl + W_UKV, 0, 8192, smem);
    } else if (s == 2) {
#if REP_MASK & 2048
        FOR_XJOBS(j, 8192) { tile_map(j, 8, tm, tn); gemm_tile<E_KV>(P, l, (const bf16_t*)(P.ws + WS_LATP) + (size_t)l * NPAST * 128, 128, Wl + W_UKV, 128, tm, tn, smem, 1); }
#endif
#if REP_MASK & 4096
        FOR_XJOBS(j, 2016) {
            if (j < 864) { tile_map(j, 6, tm, tn); gemm_tile<E_UQ>(P, l, (const bf16_t*)(P.ws + WS_CQN), 256, Wl + W_UQ, 256, tm, tn, smem, 0); }
            else { tile_map(j - 864, 8, tm, tn); gemm_tile<E_KV>(P, l, (const bf16_t*)(P.ws + WS_LATB), 128, Wl + W_UKV, 128, tm, tn, smem, 0); }
        }
#endif
        FOR_XJOBS(j, 144 + 864 + 1152) {
            if (j < 144) gla_stepB(P, l, j);
            else if (j < 1008) { tile_map(j - 144, 6, tm, tn); gemm_tile<E_UQ>(P, l, (const bf16_t*)(P.ws + WS_CQN), 256, Wl + W_UQ, 256, tm, tn, smem, 0); }
            else { tile_map(j - 1008, 8, tm, tn); gemm_tile<E_KV>(P, l, (const bf16_t*)(P.ws + WS_LATB), 128, Wl + W_UKV, 128, tm, tn, smem, 0); }
        }
    } else if (s == 3) {
        if (P.phase_end - P.phase_begin > 1) {
            FOR_DYN(j, 3072, l + 4 * rep) mixer_job(P, l, j, smem);
        } else {
            for (int j = B; j < 3072; j += G) mixer_job(P, l, j, smem);
        }
    } else if (s == 4) {
        FOR_XJOBS(j, 2304) { tile_map(j, 8, tm, tn); gemm_tile16<E_RES, 1>(P, l, (const bf16_t*)(P.ws + WS_MIX), 1024, Wl + W_OUT, 1024, tm, tn, smem); }
    } else if (s == 5) {
        FOR_XJOBS(j, 1152) { tile_map(j, 4, tm, tn); gemm_tile<E_CQ, 1>(P, l, (const bf16_t*)(P.ws + WS_XB), 1024, Wl + W_CQ, 1024, tm, tn, smem, 0); }
    } else if (s == 6) {
        for (int j = B; j < 1152; j += G) cross_job(P, l, j, smem);
    } else if (s == 7) {
        FOR_XJOBS(j, 2304) { tile_map(j, 8, tm, tn); gemm_tile16<E_RES, 1>(P, l, (const bf16_t*)(P.ws + WS_OC), 512, Wl + W_CO, 512, tm, tn, smem); }
    } else if (s == 8) {
        FOR_XJOBS(j, 6336) { tile_map(j, 44, tm, tn); gemm_tile16<E_GU, 2>(P, l, (const bf16_t*)(P.ws + WS_XB), 1024, Wl + W_GU, 1024, tm, tn, smem); }
    } else {
        FOR_XJOBS(j, 2304) { tile_map(j, 8, tm, tn); gemm_tile16<E_RES, 1>(P, l, (const bf16_t*)(P.ws + WS_ACT), 2816, Wl + W_DN, 2816, tm, tn, smem, l == 1); }
    }
}

__global__ void __launch_bounds__(256, 2) mega_kernel(Params P) {
    extern __shared__ __attribute__((aligned(16))) unsigned char smem[];
    __shared__ uint4 xb_words;
    if (threadIdx.x == 0) xb_words = make_uint4(0u, 0u, 0u, 0u);
    __syncthreads();
    const bool multi = P.phase_end - P.phase_begin > 1;
    XcdBarrier xb;
    if (multi) xb = xcd_barrier_post((unsigned*)(P.ws + WS_BAR), (volatile LAS unsigned*)&xb_words);
    else { xb.bar = nullptr; xb.x = 0; xb.st = (volatile LAS unsigned*)&xb_words; }
    if (P.phase_end < 0) cg::this_grid().sync();
    for (int ph = P.phase_begin; ph < P.phase_end; ++ph) {
        run_phase(P, ph, smem);
#if REP_MASK
        if ((ph > 0 && ((REP_MASK >> ((ph - 1) % 10)) & 1)) || (ph == 0 && (REP_MASK & 1024))) { xcd_barrier(xb); run_phase(P, ph, smem, 1); }
#endif
        if (ph + 1 < P.phase_end) xcd_barrier(xb);
    }
}

extern "C" void kernel_launch(void* const* d_in, const int* in_sizes, int n_in, void* d_out, int out_size, void* d_ws, size_t ws_size,
                              hipStream_t stream) {
    static int grid_blocks = 0;
    if (!grid_blocks) {
        hipFuncSetAttribute((const void*)mega_kernel, hipFuncAttributeMaxDynamicSharedMemorySize, SMEM_BYTES);
        int dev = 0, cus = 0, per_cu = 0;
        hipGetDevice(&dev);
        hipDeviceGetAttribute(&cus, hipDeviceAttributeMultiprocessorCount, dev);
        hipOccupancyMaxActiveBlocksPerMultiprocessor(&per_cu, mega_kernel, 256, SMEM_BYTES);
        if (per_cu < 1) per_cu = 1;
        if (per_cu > 2) per_cu = 2;
        grid_blocks = cus * per_cu;
    }
    if (ws_size < WS_END) { fprintf(stderr, "workspace too small: %zu < %zu\n", ws_size, (size_t)WS_END); return; }
    Params p{};
    for (int i = 0; i < 38; ++i) p.in[i] = (const float*)d_in[i];
    p.out = (float*)d_out;
    p.ws = (unsigned char*)d_ws;
#if ONE_LAUNCH
    p.phase_begin = 0; p.phase_end = NPHASE;
    (void)hipMemsetAsync((unsigned char*)d_ws + WS_BAR, 0, WS_END - WS_BAR, stream);
    void* args[] = {&p};
    hipError_t e = hipLaunchCooperativeKernel((const void*)mega_kernel, dim3(grid_blocks), dim3(256), args, SMEM_BYTES, stream);
    if (e != hipSuccess) fprintf(stderr, "cooperative launch failed: %s (grid %d)\n", hipGetErrorString(e), grid_blocks);
#else
    for (int ph = 0; ph < NPHASE; ++ph) {
        p.phase_begin = ph; p.phase_end = ph + 1;
        hipLaunchKernelGGL(mega_kernel, dim3(grid_blocks), dim3(256), SMEM_BYTES, stream, p);
    }
#endif
}
```

```cpp
#include <hip/hip_runtime.h>
#include <hip/hip_cooperative_groups.h>
#include <stdint.h>
#include <stdio.h>
namespace cg = cooperative_groups;

#ifndef REP_MASK
#define REP_MASK 0
#endif
#ifndef SB_PF
#define SB_PF true
#endif
#ifndef CR_PF
#define CR_PF false
#endif
#ifndef ONE_LAUNCH
#define ONE_LAUNCH 1
#endif

typedef unsigned short bf16_t;
typedef short bf16x8 __attribute__((ext_vector_type(8)));
typedef short s16x4 __attribute__((ext_vector_type(4)));
typedef float f32x16 __attribute__((ext_vector_type(16)));
typedef float f32x2 __attribute__((ext_vector_type(2)));
typedef __bf16 bf16x2n __attribute__((ext_vector_type(2)));
#define DI __device__ __forceinline__
#define MFMA32(a, b, c) __builtin_amdgcn_mfma_f32_32x32x16_bf16((a), (b), (c), 0, 0, 0)

constexpr int R_P = 16384, R_S = 2048, R_ALL = 18432;
constexpr int NPAST = 131072;
constexpr float EPS = 1e-6f;
constexpr float LOG2E = 1.4426950408889634f;
constexpr float LN2 = 0.6931471805599453f;

constexpr size_t O_Y = 0;
constexpr size_t O_SBK_P = 18874368;
constexpr size_t O_SBV_P = O_SBK_P + 8388608;
constexpr size_t O_GLA_P = O_SBV_P + 8388608;
constexpr size_t O_LAT_P = O_GLA_P + 65536;
constexpr size_t O_KR_P = O_LAT_P + 4194304;
constexpr size_t O_MEMK_P = O_KR_P + 1048576;
constexpr size_t O_MEMV_P = O_MEMK_P + 1048576;
constexpr size_t O_SBK_S = O_MEMV_P + 1048576;
constexpr size_t O_SBV_S = O_SBK_S + 1048576;
constexpr size_t O_GLA_S = O_SBV_S + 1048576;
constexpr size_t O_LAT_S = O_GLA_S + 524288;
constexpr size_t O_KR_S = O_LAT_S + 524288;

constexpr size_t W_IN = 0;
constexpr size_t W_UQ = W_IN + 2048 * 1024;
constexpr size_t W_UKV = W_UQ + 768 * 256;
constexpr size_t W_OUT = W_UKV + 1024 * 128;
constexpr size_t W_CQ = W_OUT + 1024 * 1024;
constexpr size_t W_CK = W_CQ + 512 * 1024;
constexpr size_t W_CV = W_CK + 512 * 1024;
constexpr size_t W_CO = W_CV + 512 * 1024;
constexpr size_t W_GU = W_CO + 1024 * 512;
constexpr size_t W_DN = W_GU + 5632 * 1024;
constexpr size_t W_LAYER = W_DN + 1024 * 2816;

constexpr size_t al256(size_t x) { return (x + 255) & ~(size_t)255; }
constexpr size_t WS_W = 0;
constexpr size_t WS_XB = al256(WS_W + 2 * W_LAYER * 2);
constexpr size_t WS_SSQ = al256(WS_XB + (size_t)R_ALL * 1024 * 2);
constexpr size_t WS_PROJ = al256(WS_SSQ + (size_t)R_ALL * 16 * 4);
constexpr size_t WS_CQN = al256(WS_PROJ + (size_t)R_ALL * 2048 * 2);
constexpr size_t WS_LATB = al256(WS_CQN + (size_t)R_ALL * 256 * 2);
constexpr size_t WS_KRB = al256(WS_LATB + (size_t)R_ALL * 128 * 2);
constexpr size_t WS_QN = al256(WS_KRB + (size_t)R_ALL * 32 * 2);
constexpr size_t WS_QR = al256(WS_QN + (size_t)R_ALL * 512 * 2);
constexpr size_t WS_KNB = al256(WS_QR + (size_t)R_ALL * 256 * 2);
constexpr size_t WS_VB = al256(WS_KNB + (size_t)R_ALL * 512 * 2);
constexpr size_t WS_MIX = al256(WS_VB + (size_t)R_ALL * 512 * 2);
constexpr size_t WS_QC = al256(WS_MIX + (size_t)R_ALL * 1024 * 2);
constexpr size_t WS_OC = al256(WS_QC + (size_t)R_ALL * 512 * 2);
constexpr size_t WS_ACT = al256(WS_OC + (size_t)R_ALL * 512 * 2);
constexpr size_t WS_MEMB = al256(WS_ACT + (size_t)R_ALL * 2816 * 2);
constexpr size_t WS_MEMKP = al256(WS_MEMB + (size_t)1024 * 1024 * 2);
constexpr size_t WS_MEMVP = al256(WS_MEMKP + (size_t)2 * 1024 * 512 * 2);
constexpr size_t WS_MEMKS = al256(WS_MEMVP + (size_t)2 * 1024 * 512 * 2);
constexpr size_t WS_MEMVS = al256(WS_MEMKS + (size_t)2 * 8192 * 512 * 2);
constexpr size_t WS_LATP = al256(WS_MEMVS + (size_t)2 * 8192 * 512 * 2);
constexpr size_t WS_KRP = al256(WS_LATP + (size_t)2 * NPAST * 128 * 2);
constexpr size_t WS_KNP = al256(WS_KRP + (size_t)2 * NPAST * 32 * 2);
constexpr size_t WS_VP = al256(WS_KNP + (size_t)NPAST * 512 * 2);
constexpr size_t WS_GLAB = al256(WS_VP + (size_t)NPAST * 512 * 2);
constexpr size_t WS_GLOC = al256(WS_GLAB + (size_t)1152 * 2048 * 4);
constexpr size_t WS_GDEC = al256(WS_GLOC + (size_t)1152 * 2048 * 4);
constexpr size_t WS_GST = al256(WS_GDEC + (size_t)1152 * 32 * 4);
constexpr size_t WS_BAR = al256(WS_GST + (size_t)1152 * 2048 * 4);
constexpr size_t WS_CNT = al256(WS_BAR + 3456 * 4);
constexpr size_t WS_END = al256(WS_CNT + 256);

constexpr int SMEM_BYTES = 77824;
constexpr int NPHASE = 21;

struct Params {
    const float* in[38];
    float* out;
    unsigned char* ws;
    int phase_begin, phase_end;
};

__constant__ double ROPE_REV[16] = {0.15915494309189535, 0.08949940160889101, 0.050329212104487035, 0.0283021958306234,
                                    0.015915494309189534, 0.008949940160889102, 0.005032921210448704, 0.00283021958306234,
                                    0.0015915494309189536, 0.0008949940160889102, 0.0005032921210448703, 0.00028302195830623395,
                                    0.00015915494309189535, 8.949940160889102e-05, 5.0329212104487035e-05, 2.8302195830623396e-05};

typedef unsigned u32x4 __attribute__((ext_vector_type(4)));
DI u32x4 gload16_async(const void* p) { u32x4 v; asm volatile("global_load_dwordx4 %0, %1, off" : "=v"(v) : "v"(p) : "memory"); return v; }
DI u32x4 gload16_async_nt(const void* p) { u32x4 v; asm volatile("global_load_dwordx4 %0, %1, off nt" : "=v"(v) : "v"(p) : "memory"); return v; }
DI void wait_vm0() { asm volatile("s_waitcnt vmcnt(0)" ::: "memory"); }
DI int otid() { int t = threadIdx.x; asm volatile("" : "+v"(t)); return t; }
DI float bf2f(bf16_t v) { return __uint_as_float(((unsigned)v) << 16); }
DI unsigned pack2(float a, float b) { f32x2 v = {a, b}; bf16x2n r = __builtin_convertvector(v, bf16x2n); return __builtin_bit_cast(unsigned, r); }
DI float lo16(unsigned u) { return __uint_as_float(u << 16); }
DI float hi16(unsigned u) { return __uint_as_float(u & 0xffff0000u); }
DI float wave_sum(float v) {
#pragma unroll
    for (int o = 32; o; o >>= 1) v += __shfl_xor(v, o);
    return v;
}
DI int crow(int i, int h) { return (i & 3) + 8 * (i >> 2) + 4 * h; }
DI void tile_map(const int q, const int NTN, int& tm, int& tn) { const int per = 8 * NTN; const int grp = q / per, rem = q - grp * per; tn = rem >> 3; tm = grp * 8 + (rem & 7); }
DI void rope_cs(int pos, int f, float& c, float& s) {
    double rev = (double)pos * ROPE_REV[f];
    rev -= rint(rev);
    float fr = (float)rev;
    c = __builtin_amdgcn_cosf(fr);
    s = __builtin_amdgcn_sinf(fr);
}
DI int row_pos(int row) { return row < R_P ? (row & 4095) : 4096 + ((row - R_P) & 63); }
DI float silu(float x) { return x * __builtin_amdgcn_rcpf(1.f + __builtin_amdgcn_exp2f(-x * LOG2E)); }
DI uint4 cvt8(const float* p) {
    float4 a = *(const float4*)p, b = *(const float4*)(p + 4);
    uint4 r; r.x = pack2(a.x, a.y); r.y = pack2(a.z, a.w); r.z = pack2(b.x, b.y); r.w = pack2(b.z, b.w); return r;
}


#define XB_TMO      128
#define XB_XCNT(j)  (256  + 64 * (j))
#define XB_XSUB(j)  (1280 + 64 * (j))
#define XB_XGEN(j)  (2304 + 64 * (j))
#define XB_TOP      3328
#define XB_TOPGEN   3392
#define XCD_BAR_WORDS 3456
#define XB_SPIN_CAP (1u << 20)
#define LAS __attribute__((address_space(3)))
DI unsigned xb_ld(unsigned* p) { return __hip_atomic_load(p, __ATOMIC_RELAXED, __HIP_MEMORY_SCOPE_AGENT); }
DI unsigned xb_add(unsigned* p, unsigned v) { return __hip_atomic_fetch_add(p, v, __ATOMIC_RELAXED, __HIP_MEMORY_SCOPE_AGENT); }
DI unsigned xb_xcc_id() { return (unsigned)__builtin_amdgcn_s_getreg((3 << 11) | 20) & 0xFu; }
#define XB_SPIN(cond, bar) do { unsigned _sp = 0; while (cond) { __builtin_amdgcn_s_sleep(1); \
    if ((++_sp & 255u) == 0u) { if (xb_ld(&(bar)[XB_TMO])) break; if (_sp > XB_SPIN_CAP) { atomicAdd(&(bar)[XB_TMO], 1u); break; } } } } while (0)
struct XcdBarrier { unsigned* bar; unsigned x; volatile LAS unsigned* st; };
DI XcdBarrier xcd_barrier_post(unsigned* bar, volatile LAS unsigned* st) {
    XcdBarrier b; b.bar = bar; b.x = xb_xcc_id(); b.st = st;
    if (threadIdx.x == 0) (void)xb_add(&bar[XB_XCNT(b.x)], 1u);
    return b;
}
DI void xcd_barrier_complete(unsigned* bar, unsigned x, unsigned& nloc, unsigned& nx) {
    const unsigned G = gridDim.x * gridDim.y * gridDim.z;
    unsigned sum, cnt, mine, sp = 0u;
    for (;;) {
        sum = 0u; cnt = 0u; mine = 0u;
#pragma unroll
        for (unsigned j = 0; j < 16; ++j) { const unsigned c = xb_ld(&bar[XB_XCNT(j)]); sum += c; cnt += (c > 0u) ? 1u : 0u; mine = (j == x) ? c : mine; }
        if (sum == G) break;
        __builtin_amdgcn_s_sleep(1);
        if ((++sp & 255u) == 0u) { if (xb_ld(&bar[XB_TMO])) break; if (sp > XB_SPIN_CAP) { atomicAdd(&bar[XB_TMO], 1u); break; } }
    }
    nloc = mine > 0u ? mine : 1u; nx = cnt > 0u ? cnt : 1u;
}
DI void xcd_barrier(const XcdBarrier& b) {
    asm volatile("s_waitcnt vmcnt(0)" ::: "memory");
    __syncthreads();
    if (threadIdx.x == 0) {
        unsigned* bar = b.bar;
        __builtin_amdgcn_s_waitcnt(0);
        unsigned nloc = b.st[0], nx = b.st[1];
        if (nloc == 0u) { xcd_barrier_complete(bar, b.x, nloc, nx); b.st[0] = nloc; b.st[1] = nx; }
        const unsigned old = xb_add(&bar[XB_XSUB(b.x)], 1u);
        const unsigned gen = old / nloc;
        if (old + 1u == (gen + 1u) * nloc) {
            __builtin_amdgcn_fence(__ATOMIC_RELEASE, "agent");
            asm volatile("s_waitcnt vmcnt(0)" ::: "memory");
            const unsigned og = xb_add(&bar[XB_TOP], 1u);
            const unsigned tg = og / nx;
            if (og + 1u == (tg + 1u) * nx) xb_add(&bar[XB_TOPGEN], 1u);
            else XB_SPIN(xb_ld(&bar[XB_TOPGEN]) == tg, bar);
            __builtin_amdgcn_fence(__ATOMIC_ACQUIRE, "agent");
            xb_add(&bar[XB_XGEN(b.x)], 1u);
            asm volatile("s_waitcnt vmcnt(0)" ::: "memory");
        } else {
            XB_SPIN(xb_ld(&bar[XB_XGEN(b.x)]) == gen, bar);
            __builtin_amdgcn_fence(__ATOMIC_ACQUIRE, "agent");
            asm volatile("s_waitcnt vmcnt(0)" ::: "memory");
        }
    }
    __syncthreads();
}

DI void prep_weight_tile(const Params& P, int j, unsigned char* smem) {
    float* tile = (float*)smem;
    const int l = j / 3472; int t = j % 3472;
    int wid, KT, ldsrc; size_t woff; const float* src; const float* src2 = nullptr; const float* gain = nullptr; int Kd;
    if (t < 512) { wid = 0; KT = 16; ldsrc = 1968; woff = W_IN; src = P.in[11] + (size_t)l * 1024 * 1968; gain = P.in[10] + l * 1024; Kd = 1024; }
    else if (t < 560) { t -= 512; wid = 1; KT = 4; ldsrc = 768; woff = W_UQ; src = P.in[17] + (size_t)l * 256 * 768; gain = P.in[16] + l * 256; Kd = 256; }
    else if (t < 592) { t -= 560; wid = 2; KT = 2; ldsrc = 1024; woff = W_UKV; src = P.in[22] + (size_t)l * 128 * 1024; Kd = 128; }
    else if (t < 848) { t -= 592; wid = 3; KT = 16; ldsrc = 1024; woff = W_OUT; src = P.in[25] + (size_t)l * 1024 * 1024; Kd = 1024; }
    else if (t < 976) { t -= 848; wid = 4; KT = 16; ldsrc = 512; woff = W_CQ; src = P.in[28] + (size_t)l * 1024 * 512; gain = P.in[26] + l * 1024; Kd = 1024; }
    else if (t < 1104) { t -= 976; wid = 5; KT = 16; ldsrc = 512; woff = W_CK; src = P.in[29] + (size_t)l * 1024 * 512; gain = P.in[27] + l * 1024; Kd = 1024; }
    else if (t < 1232) { t -= 1104; wid = 6; KT = 16; ldsrc = 512; woff = W_CV; src = P.in[30] + (size_t)l * 1024 * 512; gain = P.in[27] + l * 1024; Kd = 1024; }
    else if (t < 1360) { t -= 1232; wid = 7; KT = 8; ldsrc = 1024; woff = W_CO; src = P.in[33] + (size_t)l * 512 * 1024; Kd = 512; }
    else if (t < 2768) { t -= 1360; wid = 8; KT = 16; ldsrc = 2816; woff = W_GU; src = P.in[35] + (size_t)l * 1024 * 2816; src2 = P.in[36] + (size_t)l * 1024 * 2816; gain = P.in[34] + l * 1024; Kd = 1024; }
    else { t -= 2768; wid = 9; KT = 44; ldsrc = 1024; woff = W_DN; src = P.in[37] + (size_t)l * 2816 * 1024; Kd = 2816; }
    const int nt = t / KT, kt = t % KT;
    const int n0 = nt * 64, k0 = kt * 64;
    const int tid = otid();
    {
        const int tx = tid & 63, ty = tid >> 6;
        const int n = n0 + tx;
        int sc = n; const float* s = src;
        if (wid == 0) { sc = n < 1280 ? n : (n < 1952 ? n + 16 : (n < 1968 ? n - 672 : -1)); }
        else if (wid == 1) { if (n < 512) sc = (n >> 6) * 96 + (n & 63); else { int c = n - 512; sc = (c >> 5) * 96 + 64 + (c & 31); } }
        else if (wid == 2) { if (n < 512) sc = (n >> 6) * 128 + (n & 63); else { int c = n - 512; sc = (c >> 6) * 128 + 64 + (c & 63); } }
        else if (wid == 8) { int blk = n >> 6, w = n & 63; sc = blk * 32 + (w & 31); if (w >= 32) s = src2; }
        float vals[16];
#pragma unroll
        for (int i = 0; i < 16; ++i) {
            const int kk = ty + 4 * i;
            vals[i] = (sc >= 0) ? s[(size_t)(k0 + kk) * ldsrc + sc] : 0.f;
        }
        if (gain) {
#pragma unroll
            for (int i = 0; i < 16; ++i) vals[i] *= gain[k0 + ty + 4 * i];
        }
#pragma unroll
        for (int i = 0; i < 16; ++i) tile[(ty + 4 * i) * 65 + tx] = vals[i];
    }
    __syncthreads();
    {
        bf16_t* Wt = (bf16_t*)(P.ws + WS_W) + (size_t)l * W_LAYER + woff;
        const int tx = tid & 31, ty = tid >> 5;
#pragma unroll
        for (int nn = ty; nn < 64; nn += 8) {
            unsigned v = pack2(tile[(2 * tx) * 65 + nn], tile[(2 * tx + 1) * 65 + nn]);
            *(unsigned*)(Wt + (size_t)(n0 + nn) * Kd + k0 + 2 * tx) = v;
        }
    }
    __syncthreads();
}

DI void prep_x_rows(const Params& P, int j) {
    const int tid_ = otid(); const int lane = tid_ & 63, wave = tid_ >> 6;
    const int row = j * 4 + wave;
    const float* src = row < R_P ? P.in[0] + (size_t)row * 1024 : P.in[1] + (size_t)(row - R_P) * 1024;
    float* y = P.out + O_Y + (size_t)row * 1024;
    bf16_t* xb = (bf16_t*)(P.ws + WS_XB) + (size_t)row * 1024;
    float ss = 0.f;
#pragma unroll
    for (int i = 0; i < 4; ++i) {
        const int c = i * 256 + lane * 4;
        float4 v = *(const float4*)(src + c);
        *(float4*)(y + c) = v;
        uint2 b; b.x = pack2(v.x, v.y); b.y = pack2(v.z, v.w);
        *(uint2*)(xb + c) = b;
        ss += v.x * v.x + v.y * v.y + v.z * v.z + v.w * v.w;
    }
    ss = wave_sum(ss);
    float* sq = (float*)(P.ws + WS_SSQ) + (size_t)row * 16;
    if (lane < 16) sq[lane] = lane == 0 ? ss : 0.f;
}
DI void prep_mem_rows(const Params& P, int j) {
    const int tid_ = otid(); const int lane = tid_ & 63, wave = tid_ >> 6;
    const int row = j * 4 + wave;
    const float* src = P.in[2] + (size_t)row * 1024;
    bf16_t* mb = (bf16_t*)(P.ws + WS_MEMB) + (size_t)row * 1024;
    float4 v[4]; float ss = 0.f;
#pragma unroll
    for (int i = 0; i < 4; ++i) { v[i] = *(const float4*)(src + i * 256 + lane * 4); ss += v[i].x * v[i].x + v[i].y * v[i].y + v[i].z * v[i].z + v[i].w * v[i].w; }
    ss = wave_sum(ss);
    const float rinv = __builtin_amdgcn_rsqf(ss * (1.f / 1024.f) + EPS);
#pragma unroll
    for (int i = 0; i < 4; ++i) { uint2 b; b.x = pack2(v[i].x * rinv, v[i].y * rinv); b.y = pack2(v[i].z * rinv, v[i].w * rinv); *(uint2*)(mb + i * 256 + lane * 4) = b; }
}
DI void prep_convert(const Params& P, int j) {
    const float* src; bf16_t* dst; size_t off;
    if (j < 4096) { src = P.in[6]; dst = (bf16_t*)(P.ws + WS_LATP); off = (size_t)j * 8192; }
    else if (j < 5120) { src = P.in[7]; dst = (bf16_t*)(P.ws + WS_KRP); off = (size_t)(j - 4096) * 8192; }
    else if (j < 6144) { src = P.in[8]; dst = (bf16_t*)(P.ws + WS_MEMKS); off = (size_t)(j - 5120) * 8192; }
    else { src = P.in[9]; dst = (bf16_t*)(P.ws + WS_MEMVS); off = (size_t)(j - 6144) * 8192; }
    off += otid() * 8;
    float4 a[4], b[4];
#pragma unroll
    for (int i = 0; i < 4; ++i) { a[i] = *(const float4*)(src + off + i * 2048); b[i] = *(const float4*)(src + off + i * 2048 + 4); }
#pragma unroll
    for (int i = 0; i < 4; ++i) { uint4 r; r.x = pack2(a[i].x, a[i].y); r.y = pack2(a[i].z, a[i].w); r.z = pack2(b[i].x, b[i].y); r.w = pack2(b[i].z, b[i].w); *(uint4*)(dst + off + i * 2048) = r; }
}

enum { E_PROJ = 0, E_UQ, E_KV, E_RES, E_CQ, E_MEMK, E_MEMV, E_GU };

template <int EPI, int MT = 2>
DI void gemm_tile(const Params& P, const int l, const bf16_t* __restrict__ A, const int lda, const bf16_t* __restrict__ Bt, const int K,
                  const int tm, const int tn, unsigned char* smem, const int variant) {
    const int tid = otid(), lane = tid & 63, wave = tid >> 6, r = lane & 31, h = lane >> 5;
    const int wm = wave & 1, wn = wave >> 1;
    const bf16_t* Ag = A + (size_t)(tm * (64 * MT)) * lda;
    const bf16_t* Bg = Bt + (size_t)(tn * 128) * K;
    const int lrow = tid >> 3, lcc = tid & 7;
    f32x16 acc[2][MT];
#pragma unroll
    for (int a = 0; a < 2; ++a)
#pragma unroll
        for (int b = 0; b < MT; ++b)
#pragma unroll
            for (int i = 0; i < 16; ++i) acc[a][b][i] = 0.f;
    const int nk = K >> 6;
    constexpr int STGB = (64 * MT + 128) * 128;
    constexpr int BOFF = 64 * MT * 128;
    const int xr = (r >> 1) & 7;
    const int srow = lane >> 3;
    const int spos = lane & 7;
#define GLDS_ISSUE(STG, KT) { const int k0_ = (KT) * 64; unsigned char* sb_ = smem + (STG) * STGB; \
        _Pragma("unroll") for (int i = 0; i < 2 * MT; ++i) { const int blk = i * 4 + wave; const int row = blk * 8 + srow; const int c = spos ^ ((row >> 1) & 7); \
            __builtin_amdgcn_global_load_lds((const unsigned*)(Ag + (size_t)row * lda + k0_ + c * 8), (unsigned*)(sb_ + blk * 1024 + lane * 16), 16, 0, 0); } \
        _Pragma("unroll") for (int i = 0; i < 4; ++i) { const int blk = i * 4 + wave; const int row = blk * 8 + srow; const int c = spos ^ ((row >> 1) & 7); \
            __builtin_amdgcn_global_load_lds((const unsigned*)(Bg + (size_t)row * K + k0_ + c * 8), (unsigned*)(sb_ + BOFF + blk * 1024 + lane * 16), 16, 0, 0); } }
#define GLDS_FR(FS, STG, KS) { const unsigned char* cur = smem + (STG) * STGB; const int co = (((2 * (KS) + h) ^ xr) * 16); \
        _Pragma("unroll") for (int nt = 0; nt < 2; ++nt) bfr[FS][nt] = *(const bf16x8*)(cur + BOFF + (wn * 64 + 32 * nt + r) * 128 + co); \
        _Pragma("unroll") for (int mt = 0; mt < MT; ++mt) afr[FS][mt] = *(const bf16x8*)(cur + (wm * (32 * MT) + 32 * mt + r) * 128 + co); }
#define GEMM_MM(FS) { _Pragma("unroll") for (int nt = 0; nt < 2; ++nt) _Pragma("unroll") for (int mt = 0; mt < MT; ++mt) acc[nt][mt] = MFMA32(bfr[FS][nt], afr[FS][mt], acc[nt][mt]); }
    bf16x8 bfr[2][2], afr[2][MT];
    GLDS_ISSUE(0, 0);
    __syncthreads();
    for (int kt = 0; kt < nk; ++kt) {
        const int st = kt & 1;
        if (kt + 1 < nk) GLDS_ISSUE(st ^ 1, kt + 1);
        GLDS_FR(0, st, 0);
        GLDS_FR(1, st, 1); GEMM_MM(0);
        GLDS_FR(0, st, 2); GEMM_MM(1);
        GLDS_FR(1, st, 3); GEMM_MM(0);
        GEMM_MM(1);
        __syncthreads();
    }
#undef GLDS_ISSUE
#undef GLDS_FR
#undef GEMM_MM
    const int rowb = tm * (64 * MT) + wm * (32 * MT) + r;
    const int colb = tn * 128 + wn * 64 + 4 * h;
    float rinv[MT];
#pragma unroll
    for (int mt = 0; mt < MT; ++mt) rinv[mt] = 1.f;
    if (EPI == E_PROJ || EPI == E_CQ || EPI == E_GU) {
        const float* sq = (const float*)(P.ws + WS_SSQ);
#pragma unroll
        for (int mt = 0; mt < MT; ++mt) {
            const float4* p4 = (const float4*)(sq + (size_t)(rowb + 32 * mt) * 16);
            float4 a = p4[0], b = p4[1], c = p4[2], d = p4[3];
            float s = (a.x + a.y + a.z + a.w) + (b.x + b.y + b.z + b.w) + (c.x + c.y + c.z + c.w) + (d.x + d.y + d.z + d.w);
            rinv[mt] = __builtin_amdgcn_rsqf(s * (1.f / 1024.f) + EPS);
        }
    }
    if (EPI == E_PROJ) {
        bf16_t* pb = (bf16_t*)(P.ws + WS_PROJ);
        const bool kv = (tn >= 2 && tn < 6);
#pragma unroll
        for (int mt = 0; mt < MT; ++mt) {
            const int row = rowb + 32 * mt;
            float* fo = nullptr;
            if (kv) {
                const int isv = tn >= 4;
                if (row < R_P) fo = P.out + (isv ? O_SBV_P : O_SBK_P) + ((size_t)l * R_P + row) * 256;
                else fo = P.out + (isv ? O_SBV_S : O_SBK_S) + ((size_t)l * R_S + (row - R_P)) * 256;
                fo -= isv ? 512 : 256;
            }
#pragma unroll
            for (int nt = 0; nt < 2; ++nt)
#pragma unroll
                for (int g = 0; g < 4; ++g) {
                    const int col = colb + 32 * nt + 8 * g;
                    float v0 = acc[nt][mt][4 * g] * rinv[mt], v1 = acc[nt][mt][4 * g + 1] * rinv[mt], v2 = acc[nt][mt][4 * g + 2] * rinv[mt], v3 = acc[nt][mt][4 * g + 3] * rinv[mt];
                    uint2 b; b.x = pack2(v0, v1); b.y = pack2(v2, v3);
                    *(uint2*)(smem + (wm * (32 * MT) + 32 * mt + r) * 272 + (wn * 64 + 32 * nt + 8 * g + 4 * h) * 2) = b;
                    if (kv) *(float4*)(fo + col) = make_float4(v0, v1, v2, v3);
                }
        }
        __syncthreads();
#pragma unroll
        for (int it = 0; it < 4 * MT; ++it) {
            const int row = it * 16 + (tid >> 4), cc = tid & 15;
            const u32x4 v = *(const u32x4*)(smem + row * 272 + cc * 16);
            *(u32x4*)(pb + (size_t)(tm * (64 * MT) + row) * 2048 + tn * 128 + cc * 8) = v;
        }
        __syncthreads();
    } else if (EPI == E_UQ) {
        if (tn < 4) {
            bf16_t* qn = (bf16_t*)(P.ws + WS_QN);
            const float* g_qn = P.in[18] + l * 64;
            const float SC = 0.10206207261596575f * LOG2E;
            float4 ggq[2][4];
#pragma unroll
            for (int nt = 0; nt < 2; ++nt)
#pragma unroll
                for (int g = 0; g < 4; ++g) ggq[nt][g] = *(const float4*)(g_qn + 32 * nt + 8 * g + 4 * h);
#pragma unroll
            for (int mt = 0; mt < MT; ++mt) {
                const int row = rowb + 32 * mt;
                float ss = 0.f;
#pragma unroll
                for (int nt = 0; nt < 2; ++nt)
#pragma unroll
                    for (int i = 0; i < 16; ++i) ss += acc[nt][mt][i] * acc[nt][mt][i];
                ss += __shfl_xor(ss, 32);
                const float ri = __builtin_amdgcn_rsqf(ss * (1.f / 64.f) + EPS) * SC;
#pragma unroll
                for (int nt = 0; nt < 2; ++nt)
#pragma unroll
                    for (int g = 0; g < 4; ++g) {
                        const int d = 32 * nt + 8 * g + 4 * h;
                        const float4 gg = ggq[nt][g];
                        uint2 b; b.x = pack2(acc[nt][mt][4 * g] * ri * gg.x, acc[nt][mt][4 * g + 1] * ri * gg.y);
                        b.y = pack2(acc[nt][mt][4 * g + 2] * ri * gg.z, acc[nt][mt][4 * g + 3] * ri * gg.w);
                        *(uint2*)(qn + (size_t)row * 512 + tn * 128 + wn * 64 + d) = b;
                    }
            }
        } else {
            bf16_t* qr = (bf16_t*)(P.ws + WS_QR);
            const float* g_qr = P.in[19] + l * 32;
            const float SC = 0.10206207261596575f * LOG2E;
            float gqr[16];
#pragma unroll
            for (int i = 0; i < 16; ++i) gqr[i] = g_qr[crow(i, h)];
#pragma unroll
            for (int mt = 0; mt < MT; ++mt) {
                const int row = rowb + 32 * mt;
                const int pos = row_pos(row);
                float cs[8], sn[8];
#pragma unroll
                for (int i = 0; i < 8; ++i) rope_cs(pos, crow(i, h), cs[i], sn[i]);
#pragma unroll
                for (int nt = 0; nt < 2; ++nt) {
                    float ss = 0.f;
#pragma unroll
                    for (int i = 0; i < 16; ++i) ss += acc[nt][mt][i] * acc[nt][mt][i];
                    ss += __shfl_xor(ss, 32);
                    const float ri = __builtin_amdgcn_rsqf(ss * (1.f / 32.f) + EPS);
                    float y[16];
#pragma unroll
                    for (int i = 0; i < 16; ++i) y[i] = acc[nt][mt][i] * ri * gqr[i];
                    float o[16];
#pragma unroll
                    for (int i = 0; i < 8; ++i) { o[i] = (y[i] * cs[i] - y[i + 8] * sn[i]) * SC; o[i + 8] = (y[i] * sn[i] + y[i + 8] * cs[i]) * SC; }
                    const int cb = (tn - 4) * 128 + wn * 64 + 32 * nt;
#pragma unroll
                    for (int g = 0; g < 4; ++g) {
                        uint2 b; b.x = pack2(o[4 * g], o[4 * g + 1]); b.y = pack2(o[4 * g + 2], o[4 * g + 3]);
                        *(uint2*)(qr + (size_t)row * 256 + cb + 8 * g + 4 * h) = b;
                    }
                }
            }
        }
    } else if (EPI == E_KV) {
        bf16_t* dst = (bf16_t*)(P.ws + (tn < 4 ? (variant ? WS_KNP : WS_KNB) : (variant ? WS_VP : WS_VB)));
        const int dcol0 = (tn & 3) * 128;
        const float* g_kn = P.in[23] + l * 64;
#pragma unroll
        for (int mt = 0; mt < MT; ++mt) {
            float ri = 1.f;
            if (tn < 4) {
                float ss = 0.f;
#pragma unroll
                for (int nt = 0; nt < 2; ++nt)
#pragma unroll
                    for (int i = 0; i < 16; ++i) ss += acc[nt][mt][i] * acc[nt][mt][i];
                ss += __shfl_xor(ss, 32);
                ri = __builtin_amdgcn_rsqf(ss * (1.f / 64.f) + EPS);
            }
#pragma unroll
            for (int nt = 0; nt < 2; ++nt)
#pragma unroll
                for (int g = 0; g < 4; ++g) {
                    const int d = 32 * nt + 8 * g + 4 * h;
                    float4 gg = make_float4(1.f, 1.f, 1.f, 1.f);
                    if (tn < 4) gg = *(const float4*)(g_kn + d);
                    uint2 b; b.x = pack2(acc[nt][mt][4 * g] * ri * gg.x, acc[nt][mt][4 * g + 1] * ri * gg.y);
                    b.y = pack2(acc[nt][mt][4 * g + 2] * ri * gg.z, acc[nt][mt][4 * g + 3] * ri * gg.w);
                    *(uint2*)(smem + (wm * (32 * MT) + 32 * mt + r) * 272 + (wn * 64 + d) * 2) = b;
                }
        }
        __syncthreads();
#pragma unroll
        for (int it = 0; it < 4 * MT; ++it) {
            const int row = it * 16 + (tid >> 4), cc = tid & 15;
            const u32x4 v = *(const u32x4*)(smem + row * 272 + cc * 16);
            *(u32x4*)(dst + (size_t)(tm * (64 * MT) + row) * 512 + dcol0 + cc * 8) = v;
        }
        __syncthreads();
    } else if (EPI == E_RES) {
        float* x = P.out + O_Y;
        bf16_t* xb = (bf16_t*)(P.ws + WS_XB);
        float* sq = (float*)(P.ws + WS_SSQ);
        float* stg = (float*)smem;
#pragma unroll
        for (int nt = 0; nt < 2; ++nt)
#pragma unroll
            for (int g = 0; g < 4; ++g)
                *(float4*)(stg + (wm * 32 + r) * 132 + wn * 64 + 32 * nt + 8 * g + 4 * h) = make_float4(acc[nt][0][4 * g], acc[nt][0][4 * g + 1], acc[nt][0][4 * g + 2], acc[nt][0][4 * g + 3]);
        __syncthreads();
        const int l32 = tid & 31, rsub = tid >> 5;
        const int col = tn * 128 + l32 * 4;
        float4 xin[8];
#pragma unroll
        for (int it = 0; it < 8; ++it) xin[it] = *(const float4*)(x + ((size_t)tm * 64 + it * 8 + rsub) * 1024 + col);
#pragma unroll
        for (int it = 0; it < 8; ++it) {
            const int rl = it * 8 + rsub;
            const size_t row = (size_t)tm * 64 + rl;
            const float4 a = *(const float4*)(stg + rl * 132 + l32 * 4);
            float4 xo = xin[it];
            xo.x += a.x; xo.y += a.y; xo.z += a.z; xo.w += a.w;
            *(float4*)(x + row * 1024 + col) = xo;
            uint2 bb; bb.x = pack2(xo.x, xo.y); bb.y = pack2(xo.z, xo.w);
            *(uint2*)(xb + row * 1024 + col) = bb;
            float ss = xo.x * xo.x + xo.y * xo.y + xo.z * xo.z + xo.w * xo.w;
            ss += __shfl_xor(ss, 16); ss += __shfl_xor(ss, 8); ss += __shfl_xor(ss, 4); ss += __shfl_xor(ss, 2); ss += __shfl_xor(ss, 1);
            if (l32 < 2) sq[row * 16 + tn * 2 + l32] = l32 == 0 ? ss : 0.f;
        }
        __syncthreads();
    } else if (EPI == E_CQ || EPI == E_MEMK) {
        float* red = (float*)(smem + 73728);
        float ssl[MT];
#pragma unroll
        for (int mt = 0; mt < MT; ++mt) {
            float ss = 0.f;
#pragma unroll
            for (int nt = 0; nt < 2; ++nt)
#pragma unroll
                for (int i = 0; i < 16; ++i) { float v = acc[nt][mt][i] * rinv[mt]; acc[nt][mt][i] = v; ss += v * v; }
            ss += __shfl_xor(ss, 32);
            ssl[mt] = ss;
            if (h == 0) red[wn * 128 + wm * (32 * MT) + 32 * mt + r] = ss;
        }
        __syncthreads();
        const float* gn = (EPI == E_CQ ? P.in[31] : P.in[32]) + l * 128;
        const float SC = (EPI == E_CQ) ? 0.08838834764831845f * LOG2E : 1.f;
        float4 ggc[2][4];
#pragma unroll
        for (int nt = 0; nt < 2; ++nt)
#pragma unroll
            for (int g = 0; g < 4; ++g) ggc[nt][g] = *(const float4*)(gn + wn * 64 + 32 * nt + 8 * g + 4 * h);
#pragma unroll
        for (int mt = 0; mt < MT; ++mt) {
            const int row = rowb + 32 * mt;
            const float tot = ssl[mt] + red[(wn ^ 1) * 128 + wm * (32 * MT) + 32 * mt + r];
            const float ri = __builtin_amdgcn_rsqf(tot * (1.f / 128.f) + EPS) * SC;
#pragma unroll
            for (int nt = 0; nt < 2; ++nt)
#pragma unroll
                for (int g = 0; g < 4; ++g) {
                    const int d = wn * 64 + 32 * nt + 8 * g + 4 * h;
                    const float4 gg = ggc[nt][g];
                    const float v0 = acc[nt][mt][4 * g] * ri * gg.x, v1 = acc[nt][mt][4 * g + 1] * ri * gg.y, v2 = acc[nt][mt][4 * g + 2] * ri * gg.z, v3 = acc[nt][mt][4 * g + 3] * ri * gg.w;
                    uint2 b; b.x = pack2(v0, v1); b.y = pack2(v2, v3);
                    if (EPI == E_CQ) {
                        *(uint2*)((bf16_t*)(P.ws + WS_QC) + (size_t)row * 512 + tn * 128 + d) = b;
                    } else {
                        *(uint2*)((bf16_t*)(P.ws + WS_MEMKP) + ((size_t)l * 1024 + row) * 512 + tn * 128 + d) = b;
                        *(float4*)(P.out + O_MEMK_P + ((size_t)l * 1024 + row) * 512 + tn * 128 + d) = make_float4(v0, v1, v2, v3);
                    }
                }
        }
        __syncthreads();
    } else if (EPI == E_MEMV) {
#pragma unroll
        for (int mt = 0; mt < MT; ++mt) {
            const int row = rowb + 32 * mt;
#pragma unroll
            for (int nt = 0; nt < 2; ++nt)
#pragma unroll
                for (int g = 0; g < 4; ++g) {
                    const int col = colb + 32 * nt + 8 * g;
                    uint2 b; b.x = pack2(acc[nt][mt][4 * g], acc[nt][mt][4 * g + 1]); b.y = pack2(acc[nt][mt][4 * g + 2], acc[nt][mt][4 * g + 3]);
                    *(uint2*)((bf16_t*)(P.ws + WS_MEMVP) + ((size_t)l * 1024 + row) * 512 + col) = b;
                    *(float4*)(P.out + O_MEMV_P + ((size_t)l * 1024 + row) * 512 + col) = make_float4(acc[nt][mt][4 * g], acc[nt][mt][4 * g + 1], acc[nt][mt][4 * g + 2], acc[nt][mt][4 * g + 3]);
                }
        }
    } else if (EPI == E_GU) {
        bf16_t* act = (bf16_t*)(P.ws + WS_ACT);
#pragma unroll
        for (int mt = 0; mt < MT; ++mt) {
#pragma unroll
            for (int g = 0; g < 4; ++g) {
                float o[4];
#pragma unroll
                for (int e = 0; e < 4; ++e) { const float gt = acc[0][mt][4 * g + e] * rinv[mt], up = acc[1][mt][4 * g + e] * rinv[mt]; o[e] = silu(gt) * up; }
                uint2 b; b.x = pack2(o[0], o[1]); b.y = pack2(o[2], o[3]);
                *(uint2*)(smem + (wm * (32 * MT) + 32 * mt + r) * 144 + (wn * 32 + 8 * g + 4 * h) * 2) = b;
            }
        }
        __syncthreads();
#pragma unroll
        for (int it = 0; it < 2 * MT; ++it) {
            const int row = it * 32 + (tid >> 3), cc = tid & 7;
            const u32x4 v = *(const u32x4*)(smem + row * 144 + cc * 16);
            *(u32x4*)(act + (size_t)(tm * (64 * MT) + row) * 2816 + tn * 64 + cc * 8) = v;
        }
        __syncthreads();
    }
}

typedef float f32x4v __attribute__((ext_vector_type(4)));
#define MFMA16(a, b, c) __builtin_amdgcn_mfma_f32_16x16x32_bf16((a), (b), (c), 0, 0, 0)
template <int EPI, int MT>
DI void gemm_tile16(const Params& P, const int l, const bf16_t* __restrict__ A, const int lda, const bf16_t* __restrict__ Bt, const int K,
                    const int tm, const int tn, unsigned char* smem, const bool last_res = false) {
    constexpr int NMT = 2 * MT;
    const int tid = otid(), lane = tid & 63, wave = tid >> 6, i16 = lane & 15, quad = lane >> 4;
    const int wm = wave & 1, wn = wave >> 1;
    const bf16_t* Ag = A + (size_t)(tm * (64 * MT)) * lda;
    const bf16_t* Bg = Bt + (size_t)(tn * 128) * K;
    f32x4v acc[4][NMT];
#pragma unroll
    for (int a = 0; a < 4; ++a)
#pragma unroll
        for (int b = 0; b < NMT; ++b)
#pragma unroll
            for (int i = 0; i < 4; ++i) acc[a][b][i] = 0.f;
    float rinv[NMT];
#pragma unroll
    for (int mt = 0; mt < NMT; ++mt) rinv[mt] = 1.f;
    if (EPI == E_GU || EPI == E_PROJ) {
        const float* sq = (const float*)(P.ws + WS_SSQ);
#pragma unroll
        for (int mt = 0; mt < NMT; ++mt) {
            const float4* p4 = (const float4*)(sq + (size_t)(tm * (64 * MT) + wm * (32 * MT) + 16 * mt + i16) * 16);
            float4 a = p4[0], b = p4[1], c = p4[2], d = p4[3];
            float s = (a.x + a.y + a.z + a.w) + (b.x + b.y + b.z + b.w) + (c.x + c.y + c.z + c.w) + (d.x + d.y + d.z + d.w);
            rinv[mt] = __builtin_amdgcn_rsqf(s * (1.f / 1024.f) + EPS);
        }
    }
    const int nk = K >> 6;
    constexpr int STGB = (64 * MT + 128) * 128;
    constexpr int BOFF = 64 * MT * 128;
    const int xr = (i16 >> 1) & 7;
    const int srow = lane >> 3, spos = lane & 7;
#define G16_ISSUE(STG, KT) { const int k0_ = (KT) * 64; unsigned char* sb_ = smem + (STG) * STGB; \
        _Pragma("unroll") for (int i = 0; i < 2 * MT; ++i) { const int blk = i * 4 + wave; const int row = blk * 8 + srow; const int c = spos ^ ((row >> 1) & 7); \
            __builtin_amdgcn_global_load_lds((const unsigned*)(Ag + (size_t)row * lda + k0_ + c * 8), (unsigned*)(sb_ + blk * 1024 + lane * 16), 16, 0, 0); } \
        _Pragma("unroll") for (int i = 0; i < 4; ++i) { const int blk = i * 4 + wave; const int row = blk * 8 + srow; const int c = spos ^ ((row >> 1) & 7); \
            __builtin_amdgcn_global_load_lds((const unsigned*)(Bg + (size_t)row * K + k0_ + c * 8), (unsigned*)(sb_ + BOFF + blk * 1024 + lane * 16), 16, 0, 0); } }
#define G16_FR(FS, STG, KS) { const unsigned char* cur = smem + (STG) * STGB; const int co = (((4 * (KS) + quad) ^ xr) * 16); \
        _Pragma("unroll") for (int nt = 0; nt < 4; ++nt) wfr[FS][nt] = *(const bf16x8*)(cur + BOFF + (wn * 64 + 16 * nt + i16) * 128 + co); \
        _Pragma("unroll") for (int mt = 0; mt < NMT; ++mt) xfr[FS][mt] = *(const bf16x8*)(cur + (wm * (32 * MT) + 16 * mt + i16) * 128 + co); }
#define G16_MM(FS) { _Pragma("unroll") for (int nt = 0; nt < 4; ++nt) _Pragma("unroll") for (int mt = 0; mt < NMT; ++mt) acc[nt][mt] = MFMA16(wfr[FS][nt], xfr[FS][mt], acc[nt][mt]); }
    bf16x8 wfr[2][4], xfr[2][NMT];
    G16_ISSUE(0, 0);
    __syncthreads();
    for (int kt = 0; kt < nk; ++kt) {
        const int st = kt & 1;
        if (kt + 1 < nk) G16_ISSUE(st ^ 1, kt + 1);
        G16_FR(0, st, 0);
        G16_FR(1, st, 1); G16_MM(0);
        G16_MM(1);
        __syncthreads();
    }
#undef G16_ISSUE
#undef G16_FR
#undef G16_MM
    if (EPI == E_GU) {
        bf16_t* act = (bf16_t*)(P.ws + WS_ACT);
#pragma unroll
        for (int mt = 0; mt < NMT; ++mt)
#pragma unroll
            for (int nt = 0; nt < 2; ++nt) {
                float o[4];
#pragma unroll
                for (int e = 0; e < 4; ++e) { const float gt = acc[nt][mt][e] * rinv[mt], up = acc[nt + 2][mt][e] * rinv[mt]; o[e] = silu(gt) * up; }
                uint2 b; b.x = pack2(o[0], o[1]); b.y = pack2(o[2], o[3]);
                *(uint2*)(smem + (wm * (32 * MT) + 16 * mt + i16) * 144 + (wn * 32 + 16 * nt + 4 * quad) * 2) = b;
            }
        __syncthreads();
#pragma unroll
        for (int it = 0; it < 2 * MT; ++it) {
            const int row = it * 32 + (tid >> 3), cc = tid & 7;
            const u32x4 v = *(const u32x4*)(smem + row * 144 + cc * 16);
            *(u32x4*)(act + (size_t)(tm * (64 * MT) + row) * 2816 + tn * 64 + cc * 8) = v;
        }
        __syncthreads();
    } else if (EPI == E_PROJ) {
        bf16_t* pb = (bf16_t*)(P.ws + WS_PROJ);
        const bool kv = (tn >= 2 && tn < 6);
#pragma unroll
        for (int mt = 0; mt < NMT; ++mt) {
            const int rl = wm * (32 * MT) + 16 * mt + i16;
            const int row = tm * (64 * MT) + rl;
            float* fo = nullptr;
            if (kv) {
                const int isv = tn >= 4;
                if (row < R_P) fo = P.out + (isv ? O_SBV_P : O_SBK_P) + ((size_t)l * R_P + row) * 256;
                else fo = P.out + (isv ? O_SBV_S : O_SBK_S) + ((size_t)l * R_S + (row - R_P)) * 256;
                fo -= isv ? 512 : 256;
            }
#pragma unroll
            for (int nt = 0; nt < 4; ++nt) {
                const int cl = wn * 64 + 16 * nt + 4 * quad;
                const float v0 = acc[nt][mt][0] * rinv[mt], v1 = acc[nt][mt][1] * rinv[mt], v2 = acc[nt][mt][2] * rinv[mt], v3 = acc[nt][mt][3] * rinv[mt];
                uint2 bb; bb.x = pack2(v0, v1); bb.y = pack2(v2, v3);
                *(uint2*)(smem + rl * 272 + cl * 2) = bb;
                if (kv) *(float4*)(fo + tn * 128 + cl) = make_float4(v0, v1, v2, v3);
            }
        }
        __syncthreads();
#pragma unroll
        for (int it = 0; it < 4 * MT; ++it) {
            const int row = it * 16 + (tid >> 4), cc = tid & 15;
            const u32x4 v = *(const u32x4*)(smem + row * 272 + cc * 16);
            *(u32x4*)(pb + (size_t)(tm * (64 * MT) + row) * 2048 + tn * 128 + cc * 8) = v;
        }
        __syncthreads();
    } else {
        float* x = P.out + O_Y;
        bf16_t* xb = (bf16_t*)(P.ws + WS_XB);
        float* sq = (float*)(P.ws + WS_SSQ);
        float* stg = (float*)smem;
#pragma unroll
        for (int mt = 0; mt < NMT; ++mt)
#pragma unroll
            for (int nt = 0; nt < 4; ++nt)
                *(float4*)(stg + (wm * 32 + 16 * mt + i16) * 132 + wn * 64 + 16 * nt + 4 * quad) = make_float4(acc[nt][mt][0], acc[nt][mt][1], acc[nt][mt][2], acc[nt][mt][3]);
        __syncthreads();
        const int l32 = tid & 31, rsub = tid >> 5;
        const int col = tn * 128 + l32 * 4;
        float4 xin[8];
#pragma unroll
        for (int it = 0; it < 8; ++it) xin[it] = *(const float4*)(x + ((size_t)tm * 64 + it * 8 + rsub) * 1024 + col);
#pragma unroll
        for (int it = 0; it < 8; ++it) {
            const int rl = it * 8 + rsub;
            const size_t row = (size_t)tm * 64 + rl;
            const float4 a = *(const float4*)(stg + rl * 132 + l32 * 4);
            float4 xo = xin[it];
            xo.x += a.x; xo.y += a.y; xo.z += a.z; xo.w += a.w;
            *(float4*)(x + row * 1024 + col) = xo;
            if (!last_res) {
                uint2 bb; bb.x = pack2(xo.x, xo.y); bb.y = pack2(xo.z, xo.w);
                *(uint2*)(xb + row * 1024 + col) = bb;
                float ss = xo.x * xo.x + xo.y * xo.y + xo.z * xo.z + xo.w * xo.w;
                ss += __shfl_xor(ss, 16); ss += __shfl_xor(ss, 8); ss += __shfl_xor(ss, 4); ss += __shfl_xor(ss, 2); ss += __shfl_xor(ss, 1);
                if (l32 < 2) sq[row * 16 + tn * 2 + l32] = l32 == 0 ? ss : 0.f;
            }
        }
        __syncthreads();
    }
}

DI void kv_stream(const Params& P, const int l, const bf16_t* __restrict__ A, const bf16_t* __restrict__ Bt, const int first, const int count, unsigned char* smem) {
    const int tid = otid(), lane = tid & 63, wave = tid >> 6, r = lane & 31, h = lane >> 5;
    const int wm = wave & 1, wn = wave >> 1;
    const int lrow = tid >> 3, lcc = tid & 7;
    const int G = gridDim.x, B = blockIdx.x;
    const float* g_kn = P.in[23] + l * 64;
    float4 ggk[2][4];
#pragma unroll
    for (int nt = 0; nt < 2; ++nt)
#pragma unroll
        for (int g = 0; g < 4; ++g) ggk[nt][g] = *(const float4*)(g_kn + 32 * nt + 8 * g + 4 * h);
    u32x4 ra[2][4], rb[2][4];
    int tm, tn;
#define KVS_ISSUE(Q) { int tm_, tn_; tile_map(first + (Q), 8, tm_, tn_); const bf16_t* Ag = A + (size_t)(tm_ * 128) * 128; const bf16_t* Bg = Bt + (size_t)(tn_ * 128) * 128; \
        _Pragma("unroll") for (int s_ = 0; s_ < 2; ++s_) _Pragma("unroll") for (int i = 0; i < 4; ++i) { \
            ra[s_][i] = gload16_async(Ag + (size_t)(lrow + 32 * i) * 128 + s_ * 64 + lcc * 8); rb[s_][i] = gload16_async(Bg + (size_t)(lrow + 32 * i) * 128 + s_ * 64 + lcc * 8); } }
    int it = 0;
    int q = ((it * 8 + (B & 7)) * (G >> 3)) + (B >> 3);
    if (q < count) KVS_ISSUE(q);
    while (q < count) {
        tile_map(first + q, 8, tm, tn);
        wait_vm0();
#pragma unroll
        for (int s_ = 0; s_ < 2; ++s_)
#pragma unroll
            for (int i = 0; i < 4; ++i) {
                *(u32x4*)(smem + s_ * 36864 + (lrow + 32 * i) * 144 + lcc * 16) = ra[s_][i];
                *(u32x4*)(smem + s_ * 36864 + 18432 + (lrow + 32 * i) * 144 + lcc * 16) = rb[s_][i];
            }
        __syncthreads();
        ++it;
        const int qn = ((it * 8 + (B & 7)) * (G >> 3)) + (B >> 3);
        if (qn < count) KVS_ISSUE(qn);
        f32x16 acc[2][2];
#pragma unroll
        for (int a = 0; a < 2; ++a)
#pragma unroll
            for (int b = 0; b < 2; ++b)
#pragma unroll
                for (int i = 0; i < 16; ++i) acc[a][b][i] = 0.f;
#pragma unroll
        for (int kk = 0; kk < 8; ++kk) {
            const unsigned char* cur = smem + (kk >> 2) * 36864;
            const int ks = kk & 3;
            bf16x8 bf[2], af[2];
#pragma unroll
            for (int nt = 0; nt < 2; ++nt) bf[nt] = *(const bf16x8*)(cur + 18432 + (wn * 64 + 32 * nt + r) * 144 + (16 * ks + 8 * h) * 2);
#pragma unroll
            for (int mt = 0; mt < 2; ++mt) af[mt] = *(const bf16x8*)(cur + (wm * 64 + 32 * mt + r) * 144 + (16 * ks + 8 * h) * 2);
#pragma unroll
            for (int nt = 0; nt < 2; ++nt)
#pragma unroll
                for (int mt = 0; mt < 2; ++mt) acc[nt][mt] = MFMA32(bf[nt], af[mt], acc[nt][mt]);
        }
        __syncthreads();
        bf16_t* dst = (bf16_t*)(P.ws + (tn < 4 ? WS_KNP : WS_VP));
        const int dcol0 = (tn & 3) * 128;
#pragma unroll
        for (int mt = 0; mt < 2; ++mt) {
            float ri = 1.f;
            if (tn < 4) {
                float ss = 0.f;
#pragma unroll
                for (int nt = 0; nt < 2; ++nt)
#pragma unroll
                    for (int i = 0; i < 16; ++i) ss += acc[nt][mt][i] * acc[nt][mt][i];
                ss += __shfl_xor(ss, 32);
                ri = __builtin_amdgcn_rsqf(ss * (1.f / 64.f) + EPS);
            }
#pragma unroll
            for (int nt = 0; nt < 2; ++nt)
#pragma unroll
                for (int g = 0; g < 4; ++g) {
                    float4 gg = make_float4(1.f, 1.f, 1.f, 1.f);
                    if (tn < 4) gg = ggk[nt][g];
                    uint2 b; b.x = pack2(acc[nt][mt][4 * g] * ri * gg.x, acc[nt][mt][4 * g + 1] * ri * gg.y);
                    b.y = pack2(acc[nt][mt][4 * g + 2] * ri * gg.z, acc[nt][mt][4 * g + 3] * ri * gg.w);
                    *(uint2*)(smem + (wm * 64 + 32 * mt + r) * 272 + (wn * 64 + 32 * nt + 8 * g + 4 * h) * 2) = b;
                }
        }
        __syncthreads();
#pragma unroll
        for (int i2 = 0; i2 < 8; ++i2) {
            const int row = i2 * 16 + (tid >> 4), cc = tid & 15;
            const u32x4 v = *(const u32x4*)(smem + row * 272 + cc * 16);
            *(u32x4*)(dst + (size_t)(tm * 128 + row) * 512 + dcol0 + cc * 8) = v;
        }
        __syncthreads();
        q = qn;
    }
#undef KVS_ISSUE
}

DI void rowpass(const Params& P, const int l, const int j) {
    const int tid_ = otid(); const int lane = tid_ & 63, wave = tid_ >> 6;
    const int row = j * 4 + wave;
    const bf16_t* pr = (const bf16_t*)(P.ws + WS_PROJ) + (size_t)row * 2048;
    const uint2 u_cq = *(const uint2*)(pr + 1536 + lane * 4);
    const unsigned u_ckv = *(const unsigned*)(pr + 1792 + lane * 2);
    const bf16_t u_kr = pr[1920 + (lane & 31)];
    const float2 g_ckv = *(const float2*)(P.in[21] + l * 128 + lane * 2);
    const float g_kr = P.in[20][l * 32 + (lane & 31)];
    {
        float a = lo16(u_cq.x), b = hi16(u_cq.x), c = lo16(u_cq.y), d = hi16(u_cq.y);
        float ss = wave_sum(a * a + b * b + c * c + d * d);
        const float ri = __builtin_amdgcn_rsqf(ss * (1.f / 256.f) + EPS);
        uint2 o; o.x = pack2(a * ri, b * ri); o.y = pack2(c * ri, d * ri);
        *(uint2*)((bf16_t*)(P.ws + WS_CQN) + (size_t)row * 256 + lane * 4) = o;
    }
    {
        float a = lo16(u_ckv), b = hi16(u_ckv);
        float ss = wave_sum(a * a + b * b);
        const float ri = __builtin_amdgcn_rsqf(ss * (1.f / 128.f) + EPS);
        a = a * ri * g_ckv.x; b = b * ri * g_ckv.y;
        float* fo = row < R_P ? P.out + O_LAT_P + ((size_t)l * R_P + row) * 128 : P.out + O_LAT_S + ((size_t)l * R_S + (row - R_P)) * 128;
        *(float2*)(fo + lane * 2) = make_float2(a, b);
        *(unsigned*)((bf16_t*)(P.ws + WS_LATB) + (size_t)row * 128 + lane * 2) = pack2(a, b);
    }
    {
        float v = lane < 32 ? bf2f(u_kr) : 0.f;
        float ss = wave_sum(v * v);
        const float ri = __builtin_amdgcn_rsqf(ss * (1.f / 32.f) + EPS);
        float y = v * ri * g_kr;
        float other = __shfl_xor(y, 16);
        float c, s; rope_cs(row_pos(row), lane & 15, c, s);
        float o = (lane & 16) ? (other * s + y * c) : (y * c - other * s);
        if (lane < 32) {
            float* fo = row < R_P ? P.out + O_KR_P + ((size_t)l * R_P + row) * 32 : P.out + O_KR_S + ((size_t)l * R_S + (row - R_P)) * 32;
            fo[lane] = o;
            ((bf16_t*)(P.ws + WS_KRB))[(size_t)row * 32 + lane] = (bf16_t)(pack2(o, 0.f) & 0xffff);
        }
    }
}

DI void gla_job_rows(int j, int& row0, int& h) {
    if (j < 1024) { row0 = (j >> 8) * 4096 + (j & 63) * 64; h = (j >> 6) & 3; }
    else { const int s = j - 1024; row0 = R_P + (s >> 2) * 64; h = s & 3; }
}
DI void gla_stepA(const Params& P, const int l, const int j, unsigned char* smem) {
    float* lb = (float*)smem;
    float* kk = lb + 64 * 33;
    float* vv = kk + 64 * 33;
    float* agl = vv + 64 * 64;
    const int tid = otid();
    int row0, h; gla_job_rows(j, row0, h);
    const bf16_t* pb = (const bf16_t*)(P.ws + WS_PROJ);
    if (tid < 128) {
        const int t = tid >> 1, half = tid & 1;
        const uint4 ua = *(const uint4*)(pb + (size_t)(row0 + t) * 2048 + 1952 + half * 8);
        float* ap = agl + t * 16 + half * 8;
        *(float4*)ap = make_float4(lo16(ua.x), hi16(ua.x), lo16(ua.y), hi16(ua.y));
        *(float4*)(ap + 4) = make_float4(lo16(ua.z), hi16(ua.z), lo16(ua.w), hi16(ua.w));
    }
    __syncthreads();
    {
        const int t = tid >> 2, kq = (tid & 3) * 8;
        const float* Wg = P.in[12] + (size_t)l * 16 * 128 + h * 32 + kq;
        const float* bg = P.in[13] + l * 128 + h * 32 + kq;
        float z[8];
#pragma unroll
        for (int q = 0; q < 8; ++q) z[q] = bg[q];
#pragma unroll
        for (int rr = 0; rr < 16; ++rr) {
            const float a = agl[t * 16 + rr];
#pragma unroll
            for (int q = 0; q < 8; ++q) z[q] += a * Wg[rr * 128 + q];
        }
#pragma unroll
        for (int q = 0; q < 8; ++q) {
            const float zz = z[q];
            const float ls = fminf(zz, 0.f) - LN2 * __builtin_amdgcn_logf(1.f + __builtin_amdgcn_exp2f(-fabsf(zz) * LOG2E));
            lb[t * 33 + kq + q] = ls * (1.f / 16.f);
        }
    }
    __syncthreads();
    if (tid < 32) { float b = 0.f; for (int t = 0; t < 64; ++t) { b += lb[t * 33 + tid]; lb[t * 33 + tid] = b; } }
    __syncthreads();
    float* glab = (float*)(P.ws + WS_GLAB) + (size_t)(l * 0 + j) * 2048;
    for (int e = tid; e < 2048; e += 256) { const int t = e >> 5, k = e & 31; glab[e] = lb[t * 33 + k]; }
    if (tid < 32) ((float*)(P.ws + WS_GDEC))[(size_t)j * 32 + tid] = __builtin_amdgcn_exp2f(lb[63 * 33 + tid] * LOG2E);
    {
        const int token = tid >> 2, part = tid & 3;
        const uint4 uk = *(const uint4*)(pb + (size_t)(row0 + token) * 2048 + 896 + h * 32 + part * 8);
        const int c0 = tid, c1 = tid + 256;
        const uint4 uv0 = *(const uint4*)(pb + (size_t)(row0 + (c0 >> 3)) * 2048 + 1024 + h * 64 + (c0 & 7) * 8);
        const uint4 uv1 = *(const uint4*)(pb + (size_t)(row0 + (c1 >> 3)) * 2048 + 1024 + h * 64 + (c1 & 7) * 8);
        const float kv[8] = {lo16(uk.x), hi16(uk.x), lo16(uk.y), hi16(uk.y), lo16(uk.z), hi16(uk.z), lo16(uk.w), hi16(uk.w)};
#pragma unroll
        for (int i = 0; i < 8; ++i) {
            const int k = part * 8 + i;
            kk[token * 33 + k] = kv[i] * __builtin_amdgcn_exp2f((lb[63 * 33 + k] - lb[token * 33 + k]) * LOG2E);
        }
        float* v0p = vv + (c0 >> 3) * 64 + (c0 & 7) * 8;
        *(float4*)v0p = make_float4(lo16(uv0.x), hi16(uv0.x), lo16(uv0.y), hi16(uv0.y));
        *(float4*)(v0p + 4) = make_float4(lo16(uv0.z), hi16(uv0.z), lo16(uv0.w), hi16(uv0.w));
        float* v1p = vv + (c1 >> 3) * 64 + (c1 & 7) * 8;
        *(float4*)v1p = make_float4(lo16(uv1.x), hi16(uv1.x), lo16(uv1.y), hi16(uv1.y));
        *(float4*)(v1p + 4) = make_float4(lo16(uv1.z), hi16(uv1.z), lo16(uv1.w), hi16(uv1.w));
    }
    __syncthreads();
    {
        const int k = tid >> 3, v8 = (tid & 7) * 8;
        float a[8];
#pragma unroll
        for (int q = 0; q < 8; ++q) a[q] = 0.f;
        for (int t = 0; t < 64; ++t) {
            const float kv = kk[t * 33 + k];
#pragma unroll
            for (int q = 0; q < 8; ++q) a[q] += kv * vv[t * 64 + v8 + q];
        }
        float* loc = (float*)(P.ws + WS_GLOC) + (size_t)j * 2048 + k * 64 + v8;
        *(float4*)loc = make_float4(a[0], a[1], a[2], a[3]);
        *(float4*)(loc + 4) = make_float4(a[4], a[5], a[6], a[7]);
    }
    __syncthreads();
}
DI void gla_stepB(const Params& P, const int l, const int sq) {
    const int tid = otid();
    const int e0 = tid * 8, k = e0 >> 6;
    float S[8];
    int j0, nch; float* so;
    if (sq < 16) {
        j0 = sq * 64; nch = 64;
#pragma unroll
        for (int q = 0; q < 8; ++q) S[q] = 0.f;
        so = P.out + O_GLA_P + ((size_t)l * 16 + sq) * 2048;
    } else {
        const int s = sq - 16; j0 = 1024 + s; nch = 1;
        const float* s0 = P.in[5] + ((size_t)l * 128 + s) * 2048 + e0;
        float4 a = *(const float4*)s0, b = *(const float4*)(s0 + 4);
        S[0] = a.x; S[1] = a.y; S[2] = a.z; S[3] = a.w; S[4] = b.x; S[5] = b.y; S[6] = b.z; S[7] = b.w;
        so = P.out + O_GLA_S + ((size_t)l * 128 + s) * 2048;
    }
    const float* __restrict__ loc = (const float*)(P.ws + WS_GLOC);
    const float* __restrict__ dec = (const float*)(P.ws + WS_GDEC);
    float* __restrict__ st = (float*)(P.ws + WS_GST);
    for (int c0 = 0; c0 < nch; c0 += 8) {
        float4 A[8], Bv[8]; float Dd[8];
#pragma unroll
        for (int u = 0; u < 8; ++u) {
            const size_t jj = (size_t)(j0 + (c0 + u < nch ? c0 + u : nch - 1));
            Dd[u] = dec[jj * 32 + k];
            A[u] = *(const float4*)(loc + jj * 2048 + e0);
            Bv[u] = *(const float4*)(loc + jj * 2048 + e0 + 4);
        }
#pragma unroll
        for (int u = 0; u < 8; ++u) {
            if (c0 + u < nch) {
                float* sp = st + (size_t)(j0 + c0 + u) * 2048 + e0;
                *(float4*)sp = make_float4(S[0], S[1], S[2], S[3]);
                *(float4*)(sp + 4) = make_float4(S[4], S[5], S[6], S[7]);
                const float d = Dd[u];
                S[0] = d * S[0] + A[u].x; S[1] = d * S[1] + A[u].y; S[2] = d * S[2] + A[u].z; S[3] = d * S[3] + A[u].w;
                S[4] = d * S[4] + Bv[u].x; S[5] = d * S[5] + Bv[u].y; S[6] = d * S[6] + Bv[u].z; S[7] = d * S[7] + Bv[u].w;
            }
        }
    }
    *(float4*)(so + e0) = make_float4(S[0], S[1], S[2], S[3]);
    *(float4*)(so + e0 + 4) = make_float4(S[4], S[5], S[6], S[7]);
}
DI void gla_stepC(const Params& P, const int l, const int j, unsigned char* smem) {
    float* qs = (float*)smem;
    float* ks = qs + 64 * 33;
    float* att = ks + 64 * 33;
    float* vs = att + 64 * 65;
    float* Ss = vs + 64 * 64;
    const int tid = otid();
    int row0, h; gla_job_rows(j, row0, h);
    const bf16_t* pb = (const bf16_t*)(P.ws + WS_PROJ);
    const float* glab = (const float*)(P.ws + WS_GLAB) + (size_t)j * 2048;
    const float scale = 0.17677669529663687f;
    {
        const int token = tid >> 2, part = tid & 3;
        const bf16_t* prow = pb + (size_t)(row0 + token) * 2048;
        const uint4 uq = *(const uint4*)(prow + 768 + h * 32 + part * 8);
        const uint4 uk = *(const uint4*)(prow + 896 + h * 32 + part * 8);
        const float4 b0 = *(const float4*)(glab + token * 32 + part * 8), b1 = *(const float4*)(glab + token * 32 + part * 8 + 4);
        const int c0 = tid, c1 = tid + 256;
        const uint4 uv0 = *(const uint4*)(pb + (size_t)(row0 + (c0 >> 3)) * 2048 + 1024 + h * 64 + (c0 & 7) * 8);
        const uint4 uv1 = *(const uint4*)(pb + (size_t)(row0 + (c1 >> 3)) * 2048 + 1024 + h * 64 + (c1 & 7) * 8);
        const float* st = (const float*)(P.ws + WS_GST) + (size_t)j * 2048;
        const float4 s0 = *(const float4*)(st + tid * 4), s1 = *(const float4*)(st + 1024 + tid * 4);
        const float qv[8] = {lo16(uq.x), hi16(uq.x), lo16(uq.y), hi16(uq.y), lo16(uq.z), hi16(uq.z), lo16(uq.w), hi16(uq.w)};
        const float kv[8] = {lo16(uk.x), hi16(uk.x), lo16(uk.y), hi16(uk.y), lo16(uk.z), hi16(uk.z), lo16(uk.w), hi16(uk.w)};
        const float bv[8] = {b0.x, b0.y, b0.z, b0.w, b1.x, b1.y, b1.z, b1.w};
#pragma unroll
        for (int i = 0; i < 8; ++i) {
            qs[token * 33 + part * 8 + i] = qv[i] * __builtin_amdgcn_exp2f(bv[i] * LOG2E) * scale;
            ks[token * 33 + part * 8 + i] = kv[i] * __builtin_amdgcn_exp2f(-bv[i] * LOG2E);
        }
        float* v0p = vs + (c0 >> 3) * 64 + (c0 & 7) * 8;
        *(float4*)v0p = make_float4(lo16(uv0.x), hi16(uv0.x), lo16(uv0.y), hi16(uv0.y));
        *(float4*)(v0p + 4) = make_float4(lo16(uv0.z), hi16(uv0.z), lo16(uv0.w), hi16(uv0.w));
        float* v1p = vs + (c1 >> 3) * 64 + (c1 & 7) * 8;
        *(float4*)v1p = make_float4(lo16(uv1.x), hi16(uv1.x), lo16(uv1.y), hi16(uv1.y));
        *(float4*)(v1p + 4) = make_float4(lo16(uv1.z), hi16(uv1.z), lo16(uv1.w), hi16(uv1.w));
        *(float4*)(Ss + tid * 4) = s0;
        *(float4*)(Ss + 1024 + tid * 4) = s1;
    }
    __syncthreads();
    const int ty = tid >> 4, tx = tid & 15;
    {
        float a[4][4];
#pragma unroll
        for (int i = 0; i < 4; ++i)
#pragma unroll
            for (int q = 0; q < 4; ++q) a[i][q] = 0.f;
#pragma unroll 4
        for (int k = 0; k < 32; ++k) {
            float qv[4], kv[4];
#pragma unroll
            for (int i = 0; i < 4; ++i) { qv[i] = qs[(4 * ty + i) * 33 + k]; kv[i] = ks[(4 * tx + i) * 33 + k]; }
#pragma unroll
            for (int i = 0; i < 4; ++i)
#pragma unroll
                for (int q = 0; q < 4; ++q) a[i][q] += qv[i] * kv[q];
        }
#pragma unroll
        for (int i = 0; i < 4; ++i)
#pragma unroll
            for (int q = 0; q < 4; ++q) { const int t = 4 * ty + i, s = 4 * tx + q; att[t * 65 + s] = (s <= t) ? a[i][q] : 0.f; }
    }
    __syncthreads();
    {
        float o[4][4];
#pragma unroll
        for (int i = 0; i < 4; ++i)
#pragma unroll
            for (int q = 0; q < 4; ++q) o[i][q] = 0.f;
#pragma unroll 4
        for (int k = 0; k < 32; ++k) {
            float qv[4];
#pragma unroll
            for (int i = 0; i < 4; ++i) qv[i] = qs[(4 * ty + i) * 33 + k];
            const float4 sv = *(const float4*)(Ss + k * 64 + 4 * tx);
#pragma unroll
            for (int i = 0; i < 4; ++i) { o[i][0] += qv[i] * sv.x; o[i][1] += qv[i] * sv.y; o[i][2] += qv[i] * sv.z; o[i][3] += qv[i] * sv.w; }
        }
#pragma unroll 4
        for (int s = 0; s < 64; ++s) {
            float av[4];
#pragma unroll
            for (int i = 0; i < 4; ++i) av[i] = att[(4 * ty + i) * 65 + s];
            const float4 sv = *(const float4*)(vs + s * 64 + 4 * tx);
#pragma unroll
            for (int i = 0; i < 4; ++i) { o[i][0] += av[i] * sv.x; o[i][1] += av[i] * sv.y; o[i][2] += av[i] * sv.z; o[i][3] += av[i] * sv.w; }
        }
        const float4 gg = *(const float4*)(P.in[14] + l * 64 + 4 * tx);
        bf16_t* mix = (bf16_t*)(P.ws + WS_MIX);
        uint2 rgu[4];
#pragma unroll
        for (int i = 0; i < 4; ++i) rgu[i] = *(const uint2*)(pb + (size_t)(row0 + 4 * ty + i) * 2048 + 1280 + h * 64 + 4 * tx);
#pragma unroll
        for (int i = 0; i < 4; ++i) {
            float ss = o[i][0] * o[i][0] + o[i][1] * o[i][1] + o[i][2] * o[i][2] + o[i][3] * o[i][3];
            ss += __shfl_xor(ss, 1); ss += __shfl_xor(ss, 2); ss += __shfl_xor(ss, 4); ss += __shfl_xor(ss, 8);
            const float ri = __builtin_amdgcn_rsqf(ss * (1.f / 64.f) + EPS);
            const size_t row = (size_t)(row0 + 4 * ty + i);
            const uint2 ru = rgu[i];
            const float r0 = lo16(ru.x), r1 = hi16(ru.x), r2 = lo16(ru.y), r3 = hi16(ru.y);
            uint2 b; b.x = pack2(o[i][0] * ri * gg.x * silu(r0), o[i][1] * ri * gg.y * silu(r1));
            b.y = pack2(o[i][2] * ri * gg.z * silu(r2), o[i][3] * ri * gg.w * silu(r3));
            *(uint2*)(mix + row * 1024 + 256 + h * 64 + 4 * tx) = b;
        }
    }
    __syncthreads();
}

struct AttnJob {
    const bf16_t* q0; int q0s; const bf16_t* q1; int q1s;
    int NT, npast, diag;
    const bf16_t* kn0; int kn0s; const bf16_t* kn1; int kn1s; const bf16_t* vn; int vns;
    const bf16_t* kp0; int kp0s; const bf16_t* kp1; int kp1s; const bf16_t* vp; int vps;
    const float* knf; const float* vnf; const float* kpf; const float* vpf; int pfs;
    bf16_t* out; int outs; const float* gain;
};

template <int HD0, int HD1, int DV, bool F32OK, int NTH, int NKR, int NVR>
DI void attn_issue_tile(const AttnJob& J, const int kt, u32x4 (&tk)[NKR], u32x4 (&tv)[NVR], const int p) {
    constexpr int CK = (HD0 + HD1) / 8, CV = DV / 8, NK = 64 * CK / NTH, NV = 64 * CV / NTH;
    const bool past = kt < J.npast;
    const int key0 = past ? kt * 64 : (kt - J.npast) * 64;
    if constexpr (F32OK) {
        const float* kb = past ? J.kpf : J.knf;
        const float* vb = past ? J.vpf : J.vnf;
#pragma unroll
        for (int i = 0; i < NK; ++i) {
            const int c = p + NTH * i, key = c / CK, part = c % CK;
            const float* s = kb + (size_t)(key0 + key) * J.pfs + part * 8;
            tk[2 * i] = gload16_async_nt(s); tk[2 * i + 1] = gload16_async_nt(s + 4);
        }
#pragma unroll
        for (int i = 0; i < NV; ++i) {
            const int c = p + NTH * i, key = c / CV, part = c % CV;
            const float* s = vb + (size_t)(key0 + key) * J.pfs + part * 8;
            tv[2 * i] = gload16_async_nt(s); tv[2 * i + 1] = gload16_async_nt(s + 4);
        }
    } else {
        const bf16_t* k0 = past ? J.kp0 : J.kn0; const int k0s = past ? J.kp0s : J.kn0s;
        const bf16_t* k1 = past ? J.kp1 : J.kn1; const int k1s = past ? J.kp1s : J.kn1s;
        const bf16_t* vsrc = past ? J.vp : J.vn; const int vss = past ? J.vps : J.vns;
#pragma unroll
        for (int i = 0; i < NK; ++i) {
            const int c = p + NTH * i, key = c / CK, part = c % CK;
            const bf16_t* s;
            if (HD1 == 0 || part < HD0 / 8) s = k0 + (size_t)(key0 + key) * k0s + part * 8;
            else s = k1 + (size_t)(key0 + key) * k1s + (part - HD0 / 8) * 8;
            tk[i] = gload16_async(s);
        }
#pragma unroll
        for (int i = 0; i < NV; ++i) {
            const int c = p + NTH * i, key = c / CV, part = c % CV;
            tv[i] = gload16_async(vsrc + (size_t)(key0 + key) * vss + part * 8);
        }
    }
}
DI u32x4 cvt8r(const u32x4 a, const u32x4 b) {
    u32x4 r;
    r.x = pack2(__uint_as_float(a.x), __uint_as_float(a.y)); r.y = pack2(__uint_as_float(a.z), __uint_as_float(a.w));
    r.z = pack2(__uint_as_float(b.x), __uint_as_float(b.y)); r.w = pack2(__uint_as_float(b.z), __uint_as_float(b.w));
    return r;
}
DI void vt_scatter(bf16_t* vt, const u32x4 u) {
    vt[0] = u.x & 0xffff; vt[68] = u.x >> 16; vt[136] = u.y & 0xffff; vt[204] = u.y >> 16;
    vt[272] = u.z & 0xffff; vt[340] = u.z >> 16; vt[408] = u.w & 0xffff; vt[476] = u.w >> 16;
}
template <int HD0, int HD1, int DV, bool F32OK, int NTH, int NKR, int NVR>
DI void attn_store_tile(const AttnJob& J, const int kt, const u32x4 (&tk)[NKR], const u32x4 (&tv)[NVR], unsigned char* Ks, unsigned char* Vt, const int p) {
    constexpr int HD = HD0 + HD1, CK = HD / 8, CV = DV / 8, KSTR = (HD + 8) * 2, NK = 64 * CK / NTH, NV = 64 * CV / NTH;
#pragma unroll
    for (int i = 0; i < NK; ++i) {
        const int c = p + NTH * i, key = c / CK, part = c % CK;
        u32x4 u;
        if constexpr (F32OK) u = cvt8r(tk[2 * i], tk[2 * i + 1]); else u = tk[i];
        *(u32x4*)(Ks + key * KSTR + part * 16) = u;
    }
#pragma unroll
    for (int i = 0; i < NV; ++i) {
        const int c = p + NTH * i, key = c / CV, part = c % CV;
        u32x4 u;
        if constexpr (F32OK) u = cvt8r(tv[2 * i], tv[2 * i + 1]); else u = tv[i];
        *(u32x4*)(Vt + key * (DV * 2 + 16) + part * 16) = u;
    }
}

template <int MODE, int HD0, int HD1, int DV, bool F32OK, bool PF>
DI void attn_job(const AttnJob& J, unsigned char* smem) {
    constexpr int HD = HD0 + HD1, NKS = HD / 16, NDT = DV / 32, KSTR = (HD + 8) * 2;
    constexpr int VSTR = DV * 2 + 16;
    constexpr int KBYTES = 64 * KSTR, VBYTES = 64 * VSTR, PAIRB = KBYTES + VBYTES;
    const int tid = otid(), lane = tid & 63, wave = tid >> 6, r = lane & 31, h = lane >> 5;
    const int qh = wave & 1, kh = wave >> 1, p = tid & 127;
    unsigned char* Ks = smem + kh * PAIRB;
    unsigned char* Vt = Ks + KBYTES;
    const int NT = J.NT, n0 = (NT + 1) >> 1, n1 = NT - n0;
    constexpr int NKR = (64 * (HD / 8) / 128) * (F32OK ? 2 : 1), NVR = (64 * (DV / 8) / 128) * (F32OK ? 2 : 1);
    u32x4 tk[NKR], tv[NVR];
    {
        const int kt0 = kh == 0 ? NT - 1 : n1 - 1;
        if (PF && kt0 >= 0) attn_issue_tile<HD0, HD1, DV, F32OK, 128>(J, kt0, tk, tv, p);
    }
    bf16x8 qf[NKS];
#pragma unroll
    for (int ks = 0; ks < NKS; ++ks) {
        if (16 * ks < HD0) qf[ks] = *(const bf16x8*)(J.q0 + (size_t)(32 * qh + r) * J.q0s + 16 * ks + 8 * h);
        else qf[ks] = *(const bf16x8*)(J.q1 + (size_t)(32 * qh + r) * J.q1s + (16 * ks - HD0) + 8 * h);
    }
    f32x16 oT[NDT];
#pragma unroll
    for (int dt = 0; dt < NDT; ++dt)
#pragma unroll
        for (int i = 0; i < 16; ++i) oT[dt][i] = 0.f;
    float m_run = -1e30f, l_run = 0.f, R = (MODE == 1) ? 1.f : 0.f;
    for (int it = 0; it < n0; ++it) {
        const int kt = kh == 0 ? NT - 1 - it : n1 - 1 - it;
        const bool active = kt >= 0;
        if (!PF && active) attn_issue_tile<HD0, HD1, DV, F32OK, 128>(J, kt, tk, tv, p);
        wait_vm0();
        __syncthreads();
        if (active) attn_store_tile<HD0, HD1, DV, F32OK, 128>(J, kt, tk, tv, Ks, Vt, p);
        __syncthreads();
        if (PF && it + 1 < n0 && kt - 1 >= 0) attn_issue_tile<HD0, HD1, DV, F32OK, 128>(J, kt - 1, tk, tv, p);
        if (!active) continue;
        f32x16 sT[2];
#pragma unroll
        for (int mt = 0; mt < 2; ++mt) {
#pragma unroll
            for (int i = 0; i < 16; ++i) sT[mt][i] = 0.f;
#pragma unroll
            for (int ks = 0; ks < NKS; ++ks) {
                const bf16x8 a = *(const bf16x8*)(Ks + (32 * mt + r) * KSTR + (16 * ks + 8 * h) * 2);
                sT[mt] = MFMA32(a, qf[ks], sT[mt]);
            }
        }
        if (MODE == 0) {
            float mx = sT[0][0];
#pragma unroll
            for (int mt = 0; mt < 2; ++mt)
#pragma unroll
                for (int i = 0; i < 16; ++i) mx = fmaxf(mx, sT[mt][i]);
            mx = fmaxf(mx, __shfl_xor(mx, 32));
            const float m_new = fmaxf(m_run, mx);
            const float alpha = __builtin_amdgcn_exp2f(m_run - m_new);
            m_run = m_new;
            float ps = 0.f;
#pragma unroll
            for (int mt = 0; mt < 2; ++mt)
#pragma unroll
                for (int i = 0; i < 16; ++i) { const float pv = __builtin_amdgcn_exp2f(sT[mt][i] - m_new); sT[mt][i] = pv; ps += pv; }
            l_run = l_run * alpha + ps;
#pragma unroll
            for (int dt = 0; dt < NDT; ++dt)
#pragma unroll
                for (int i = 0; i < 16; ++i) oT[dt][i] *= alpha;
        } else {
            const bool dg = J.diag && (kt == NT - 1);
            const int qi = 32 * qh + r;
            float kp[2][16];
#pragma unroll
            for (int mt = 0; mt < 2; ++mt)
#pragma unroll
                for (int i = 0; i < 16; ++i) {
                    const float t = fminf(sT[mt][i] * (-0.125f * LOG2E), 115.f);
                    const float e = __builtin_amdgcn_exp2f(t);
                    const float sg = __builtin_amdgcn_rcpf(1.f + e);
                    const bool masked = dg && (32 * mt + crow(i, h) >= qi);
                    sT[mt][i] = masked ? 0.f : sg;
                    kp[mt][i] = masked ? 1.f : e * sg;
                }
            float G[2][4], Go[2][4];
#pragma unroll
            for (int mt = 0; mt < 2; ++mt)
#pragma unroll
                for (int g = 0; g < 4; ++g) {
                    G[mt][g] = (kp[mt][4 * g] * kp[mt][4 * g + 1]) * (kp[mt][4 * g + 2] * kp[mt][4 * g + 3]);
                    Go[mt][g] = __shfl_xor(G[mt][g], 32);
                }
            float run = R;
#pragma unroll
            for (int mt = 1; mt >= 0; --mt)
#pragma unroll
                for (int g = 3; g >= 0; --g) {
                    const float after = h ? run : run * Go[mt][g];
                    const float p3 = after, p2 = p3 * kp[mt][4 * g + 3], p1 = p2 * kp[mt][4 * g + 2], p0 = p1 * kp[mt][4 * g + 1];
                    sT[mt][4 * g + 3] *= p3;
                    sT[mt][4 * g + 2] *= p2;
                    sT[mt][4 * g + 1] *= p1;
                    sT[mt][4 * g + 0] *= p0;
                    run *= G[mt][g] * Go[mt][g];
                }
            R = run;
        }
#pragma unroll
        for (int mt = 0; mt < 2; ++mt)
#pragma unroll
            for (int s = 0; s < 2; ++s) {
                uint4 pu;
                pu.x = pack2(sT[mt][8 * s], sT[mt][8 * s + 1]); pu.y = pack2(sT[mt][8 * s + 2], sT[mt][8 * s + 3]);
                pu.z = pack2(sT[mt][8 * s + 4], sT[mt][8 * s + 5]); pu.w = pack2(sT[mt][8 * s + 6], sT[mt][8 * s + 7]);
                const bf16x8 pf = __builtin_bit_cast(bf16x8, pu);
#pragma unroll
                for (int dt = 0; dt < NDT; ++dt) {
                    const unsigned char* vp = Vt + (32 * mt + 16 * s + 4 * h + ((lane & 15) >> 2)) * VSTR + dt * 64 + ((lane >> 4) & 1) * 32 + (lane & 3) * 8;
                    const s16x4 a0 = __builtin_amdgcn_ds_read_tr16_b64_v4i16((LAS s16x4*)vp);
                    const s16x4 a1 = __builtin_amdgcn_ds_read_tr16_b64_v4i16((LAS s16x4*)(vp + 8 * VSTR));
                    const bf16x8 av = __builtin_shufflevector(a0, a1, 0, 1, 2, 3, 4, 5, 6, 7);
                    oT[dt] = MFMA32(av, pf, oT[dt]);
                }
            }
    }
    __syncthreads();
    float* X = (float*)smem + (size_t)qh * (NDT * 16 + 2) * 64;
    if (kh == 1) {
#pragma unroll
        for (int dt = 0; dt < NDT; ++dt)
#pragma unroll
            for (int i = 0; i < 16; ++i) X[(dt * 16 + i) * 64 + lane] = oT[dt][i];
        X[(NDT * 16) * 64 + lane] = MODE == 0 ? m_run : R;
        X[(NDT * 16 + 1) * 64 + lane] = l_run;
    }
    __syncthreads();
    if (kh == 0) {
        if (MODE == 0) {
            const float m1 = X[(NDT * 16) * 64 + lane], l1 = X[(NDT * 16 + 1) * 64 + lane];
            const float m = fmaxf(m_run, m1);
            const float a0 = __builtin_amdgcn_exp2f(m_run - m), a1 = __builtin_amdgcn_exp2f(m1 - m);
            float lt = l_run * a0 + l1 * a1;
            lt += __shfl_xor(lt, 32);
            const float inv = __builtin_amdgcn_rcpf(lt);
#pragma unroll
            for (int dt = 0; dt < NDT; ++dt)
#pragma unroll
                for (int i = 0; i < 16; ++i) oT[dt][i] = (oT[dt][i] * a0 + X[(dt * 16 + i) * 64 + lane] * a1) * inv;
        } else {
            const float f = R;
#pragma unroll
            for (int dt = 0; dt < NDT; ++dt)
#pragma unroll
                for (int i = 0; i < 16; ++i) oT[dt][i] += f * X[(dt * 16 + i) * 64 + lane];
        }
        float ri = 1.f;
        if (J.gain) {
            float ss = 0.f;
#pragma unroll
            for (int dt = 0; dt < NDT; ++dt)
#pragma unroll
                for (int i = 0; i < 16; ++i) ss += oT[dt][i] * oT[dt][i];
            ss += __shfl_xor(ss, 32);
            ri = __builtin_amdgcn_rsqf(ss * (1.f / DV) + EPS);
        }
        bf16_t* orow = J.out + (size_t)(32 * qh + r) * J.outs;
        float4 ggv[NDT][4];
#pragma unroll
        for (int dt = 0; dt < NDT; ++dt)
#pragma unroll
            for (int g = 0; g < 4; ++g) ggv[dt][g] = J.gain ? *(const float4*)(J.gain + 32 * dt + 8 * g + 4 * h) : make_float4(1.f, 1.f, 1.f, 1.f);
#pragma unroll
        for (int dt = 0; dt < NDT; ++dt)
#pragma unroll
            for (int g = 0; g < 4; ++g) {
                const int d = 32 * dt + 8 * g + 4 * h;
                const float4 gg = ggv[dt][g];
                uint2 b; b.x = pack2(oT[dt][4 * g] * ri * gg.x, oT[dt][4 * g + 1] * ri * gg.y); b.y = pack2(oT[dt][4 * g + 2] * ri * gg.z, oT[dt][4 * g + 3] * ri * gg.w);
                *(uint2*)(orow + d) = b;
            }
    }
    __syncthreads();
}

template <int MODE, int HD0, int HD1, int DV>
DI void attn_job128(const AttnJob& J, const int qt2, unsigned char* smem) {
    constexpr int HD = HD0 + HD1, NKS = HD / 16, NDT = DV / 32, KSTR = (HD + 8) * 2, VSTR = DV * 2 + 16;
    constexpr int KBYTES = 64 * KSTR, VBYTES = 64 * VSTR, BUFB = KBYTES + VBYTES;
    const int tid = otid(), lane = tid & 63, wave = tid >> 6, r = lane & 31, h = lane >> 5;
    const int my_last = 2 * qt2 + (wave >> 1);
    const int NT = 2 * qt2 + 2;
    constexpr int NKR = 64 * (HD / 8) / 256, NVR = 64 * (DV / 8) / 256;
    u32x4 tk[NKR], tv[NVR];
    attn_issue_tile<HD0, HD1, DV, false, 256>(J, NT - 1, tk, tv, tid);
    bf16x8 qf[NKS];
#pragma unroll
    for (int ks = 0; ks < NKS; ++ks) {
        if (16 * ks < HD0) qf[ks] = *(const bf16x8*)(J.q0 + (size_t)(32 * wave + r) * J.q0s + 16 * ks + 8 * h);
        else qf[ks] = *(const bf16x8*)(J.q1 + (size_t)(32 * wave + r) * J.q1s + (16 * ks - HD0) + 8 * h);
    }
    f32x16 oT[NDT];
#pragma unroll
    for (int dt = 0; dt < NDT; ++dt)
#pragma unroll
        for (int i = 0; i < 16; ++i) oT[dt][i] = 0.f;
    float m_run = -1e30f, l_run = 0.f, R = (MODE == 1) ? 1.f : 0.f;
    for (int it = 0; it < NT; ++it) {
        const int kt = NT - 1 - it;
        unsigned char* Ks = smem + (it & 1) * BUFB;
        unsigned char* Vt = Ks + KBYTES;
        wait_vm0();
        attn_store_tile<HD0, HD1, DV, false, 256>(J, kt, tk, tv, Ks, Vt, tid);
        __syncthreads();
        if (it + 1 < NT) attn_issue_tile<HD0, HD1, DV, false, 256>(J, kt - 1, tk, tv, tid);
        if (kt > my_last) continue;
        f32x16 sT[2];
#pragma unroll
        for (int mt = 0; mt < 2; ++mt) {
#pragma unroll
            for (int i = 0; i < 16; ++i) sT[mt][i] = 0.f;
#pragma unroll
            for (int ks = 0; ks < NKS; ++ks) {
                const bf16x8 a = *(const bf16x8*)(Ks + (32 * mt + r) * KSTR + (16 * ks + 8 * h) * 2);
                sT[mt] = MFMA32(a, qf[ks], sT[mt]);
            }
        }
        if (MODE == 0) {
            float mx = sT[0][0];
#pragma unroll
            for (int mt = 0; mt < 2; ++mt)
#pragma unroll
                for (int i = 0; i < 16; ++i) mx = fmaxf(mx, sT[mt][i]);
            mx = fmaxf(mx, __shfl_xor(mx, 32));
            const float m_new = fmaxf(m_run, mx);
            const float alpha = __builtin_amdgcn_exp2f(m_run - m_new);
            m_run = m_new;
            float ps = 0.f;
#pragma unroll
            for (int mt = 0; mt < 2; ++mt)
#pragma unroll
                for (int i = 0; i < 16; ++i) { const float pv = __builtin_amdgcn_exp2f(sT[mt][i] - m_new); sT[mt][i] = pv; ps += pv; }
            l_run = l_run * alpha + ps;
#pragma unroll
            for (int dt = 0; dt < NDT; ++dt)
#pragma unroll
                for (int i = 0; i < 16; ++i) oT[dt][i] *= alpha;
        } else {
            const bool dg = (kt == my_last);
            const int qi = 32 * (wave & 1) + r;
            float kp[2][16];
#pragma unroll
            for (int mt = 0; mt < 2; ++mt)
#pragma unroll
                for (int i = 0; i < 16; ++i) {
                    const float t = fminf(sT[mt][i] * (-0.125f * LOG2E), 115.f);
                    const float e = __builtin_amdgcn_exp2f(t);
                    const float sg = __builtin_amdgcn_rcpf(1.f + e);
                    const bool masked = dg && (32 * mt + crow(i, h) >= qi);
                    sT[mt][i] = masked ? 0.f : sg;
                    kp[mt][i] = masked ? 1.f : e * sg;
                }
            float G[2][4], Go[2][4];
#pragma unroll
            for (int mt = 0; mt < 2; ++mt)
#pragma unroll
                for (int g = 0; g < 4; ++g) {
                    G[mt][g] = (kp[mt][4 * g] * kp[mt][4 * g + 1]) * (kp[mt][4 * g + 2] * kp[mt][4 * g + 3]);
                    Go[mt][g] = __shfl_xor(G[mt][g], 32);
                }
            float run = R;
#pragma unroll
            for (int mt = 1; mt >= 0; --mt)
#pragma unroll
                for (int g = 3; g >= 0; --g) {
                    const float after = h ? run : run * Go[mt][g];
                    const float p3 = after, p2 = p3 * kp[mt][4 * g + 3], p1 = p2 * kp[mt][4 * g + 2], p0 = p1 * kp[mt][4 * g + 1];
                    sT[mt][4 * g + 3] *= p3;
                    sT[mt][4 * g + 2] *= p2;
                    sT[mt][4 * g + 1] *= p1;
                    sT[mt][4 * g + 0] *= p0;
                    run *= G[mt][g] * Go[mt][g];
                }
            R = run;
        }
#pragma unroll
        for (int mt = 0; mt < 2; ++mt)
#pragma unroll
            for (int s = 0; s < 2; ++s) {
                uint4 pu;
                pu.x = pack2(sT[mt][8 * s], sT[mt][8 * s + 1]); pu.y = pack2(sT[mt][8 * s + 2], sT[mt][8 * s + 3]);
                pu.z = pack2(sT[mt][8 * s + 4], sT[mt][8 * s + 5]); pu.w = pack2(sT[mt][8 * s + 6], sT[mt][8 * s + 7]);
                const bf16x8 pf = __builtin_bit_cast(bf16x8, pu);
#pragma unroll
                for (int dt = 0; dt < NDT; ++dt) {
                    const unsigned char* vp = Vt + (32 * mt + 16 * s + 4 * h + ((lane & 15) >> 2)) * VSTR + dt * 64 + ((lane >> 4) & 1) * 32 + (lane & 3) * 8;
                    const s16x4 a0 = __builtin_amdgcn_ds_read_tr16_b64_v4i16((LAS s16x4*)vp);
                    const s16x4 a1 = __builtin_amdgcn_ds_read_tr16_b64_v4i16((LAS s16x4*)(vp + 8 * VSTR));
                    const bf16x8 av = __builtin_shufflevector(a0, a1, 0, 1, 2, 3, 4, 5, 6, 7);
                    oT[dt] = MFMA32(av, pf, oT[dt]);
                }
            }
    }
    {
        float inv = 1.f;
        if (MODE == 0) { float lt = l_run + __shfl_xor(l_run, 32); inv = __builtin_amdgcn_rcpf(lt); }
        float ss = 0.f;
#pragma unroll
        for (int dt = 0; dt < NDT; ++dt)
#pragma unroll
            for (int i = 0; i < 16; ++i) { oT[dt][i] *= inv; ss += oT[dt][i] * oT[dt][i]; }
        ss += __shfl_xor(ss, 32);
        const float ri = __builtin_amdgcn_rsqf(ss * (1.f / DV) + EPS);
        bf16_t* orow = J.out + (size_t)(32 * wave + r) * J.outs;
        float4 ggv[NDT][4];
#pragma unroll
        for (int dt = 0; dt < NDT; ++dt)
#pragma unroll
            for (int g = 0; g < 4; ++g) ggv[dt][g] = *(const float4*)(J.gain + 32 * dt + 8 * g + 4 * h);
#pragma unroll
        for (int dt = 0; dt < NDT; ++dt)
#pragma unroll
            for (int g = 0; g < 4; ++g) {
                const int d = 32 * dt + 8 * g + 4 * h;
                const float4 gg = ggv[dt][g];
                uint2 b; b.x = pack2(oT[dt][4 * g] * ri * gg.x, oT[dt][4 * g + 1] * ri * gg.y); b.y = pack2(oT[dt][4 * g + 2] * ri * gg.z, oT[dt][4 * g + 3] * ri * gg.w);
                *(uint2*)(orow + d) = b;
            }
    }
    __syncthreads();
}

DI void mixer_job(const Params& P, const int l, const int j, unsigned char* smem) {
    const bf16_t* pb = (const bf16_t*)(P.ws + WS_PROJ);
    bf16_t* mix = (bf16_t*)(P.ws + WS_MIX);
    if (j >= 1920) { gla_stepC(P, l, 2 * (j - 1920), smem); gla_stepC(P, l, 2 * (j - 1920) + 1, smem); return; }
    AttnJob J;
    J.q1 = nullptr; J.q1s = 0; J.kn1 = nullptr; J.kn1s = 0; J.kp0 = nullptr; J.kp0s = 0; J.kp1 = nullptr; J.kp1s = 0; J.vp = nullptr; J.vps = 0;
    J.kpf = nullptr; J.vpf = nullptr; J.knf = nullptr; J.vnf = nullptr; J.pfs = 0; J.npast = 0; J.diag = 0; J.NT = 0;
    bool sb; int b, h, qt; bool sample;
    int s_idx = -1, level = 0, w = 0;
    if (j < 1152) { level = j / 72; const int w72 = j - level * 72; if (w72 < 24) s_idx = level * 24 + w72; else w = w72 - 24; }
    else { const int jj = j - 1152; level = 16 + jj / 48; w = jj % 48; }
    if (s_idx >= 0) {
        sample = true; qt = 0;
        if (s_idx < 128) { sb = true; b = s_idx >> 2; h = s_idx & 3; }
        else { const int ss = s_idx - 128; sb = false; b = ss >> 3; h = ss & 7; }
    } else {
        sample = false; qt = 2 * (31 - level);
        if (w < 32) { sb = false; b = w >> 3; h = w & 7; } else { sb = true; b = (w - 32) >> 2; h = (w - 32) & 3; }
    }
    const size_t seq0 = sample ? (size_t)R_P + b * 64 : (size_t)b * 4096;
    const size_t qrow = seq0 + (size_t)qt * 64;
    if (sb) {
        J.q0 = pb + qrow * 2048 + h * 64; J.q0s = 2048;
        J.kn0 = pb + seq0 * 2048 + 256 + h * 64; J.kn0s = 2048;
        J.vn = pb + seq0 * 2048 + 512 + h * 64; J.vns = 2048;
        J.diag = 1;
        J.out = mix + qrow * 1024 + h * 64; J.outs = 1024; J.gain = P.in[15] + l * 64;
        if (sample) {
            J.NT = 65; J.npast = 64;
            J.kpf = P.in[3] + ((((size_t)l * 32 + b) * 4096) * 4 + h) * 64;
            J.vpf = P.in[4] + ((((size_t)l * 32 + b) * 4096) * 4 + h) * 64;
            J.knf = P.out + O_SBK_S + (((size_t)l * 32 + b) * 64) * 256 + h * 64;
            J.vnf = P.out + O_SBV_S + (((size_t)l * 32 + b) * 64) * 256 + h * 64;
            J.pfs = 256;
            attn_job<1, 64, 0, 64, true, SB_PF>(J, smem);
        } else {
            attn_job128<1, 64, 0, 64>(J, qt >> 1, smem);
        }
    } else {
        J.q0 = (const bf16_t*)(P.ws + WS_QN) + qrow * 512 + h * 64; J.q0s = 512;
        J.q1 = (const bf16_t*)(P.ws + WS_QR) + qrow * 256 + h * 32; J.q1s = 256;
        J.kn0 = (const bf16_t*)(P.ws + WS_KNB) + seq0 * 512 + h * 64; J.kn0s = 512;
        J.kn1 = (const bf16_t*)(P.ws + WS_KRB) + seq0 * 32; J.kn1s = 32;
        J.vn = (const bf16_t*)(P.ws + WS_VB) + seq0 * 512 + h * 64; J.vns = 512;
        if (sample) {
            J.NT = 65; J.npast = 64;
            J.kp0 = (const bf16_t*)(P.ws + WS_KNP) + ((size_t)b * 4096) * 512 + h * 64; J.kp0s = 512;
            J.kp1 = (const bf16_t*)(P.ws + WS_KRP) + ((size_t)l * NPAST + (size_t)b * 4096) * 32; J.kp1s = 32;
            J.vp = (const bf16_t*)(P.ws + WS_VP) + ((size_t)b * 4096) * 512 + h * 64; J.vps = 512;
        }
        J.out = mix + qrow * 1024 + 512 + h * 64; J.outs = 1024; J.gain = P.in[24] + l * 64;
        if (sample) attn_job<0, 64, 32, 64, false, true>(J, smem);
        else attn_job128<0, 64, 32, 64>(J, qt >> 1, smem);
    }
}
DI void cross_job(const Params& P, const int l, const int j, unsigned char* smem) {
    AttnJob J;
    J.q1 = nullptr; J.q1s = 0; J.kn1 = nullptr; J.kn1s = 0; J.kp0 = nullptr; J.kp0s = 0; J.kp1 = nullptr; J.kp1s = 0; J.vp = nullptr; J.vps = 0;
    J.kpf = nullptr; J.vpf = nullptr; J.knf = nullptr; J.vnf = nullptr; J.pfs = 0; J.npast = 0; J.diag = 0; J.NT = 4; J.gain = nullptr;
    size_t qrow; int h;
    if (j < 1024) {
        const int qt = j & 63, b = j >> 8; h = (j >> 6) & 3;
        qrow = (size_t)b * 4096 + qt * 64;
        J.kn0 = (const bf16_t*)(P.ws + WS_MEMKP) + ((size_t)l * 1024 + b * 256) * 512 + h * 128;
        J.vn = (const bf16_t*)(P.ws + WS_MEMVP) + ((size_t)l * 1024 + b * 256) * 512 + h * 128;
    } else {
        const int s = j - 1024, b = s >> 2; h = s & 3;
        qrow = (size_t)R_P + b * 64;
        J.kn0 = (const bf16_t*)(P.ws + WS_MEMKS) + (((size_t)l * 32 + b) * 256) * 512 + h * 128;
        J.vn = (const bf16_t*)(P.ws + WS_MEMVS) + (((size_t)l * 32 + b) * 256) * 512 + h * 128;
    }
    J.kn0s = 512; J.vns = 512;
    J.q0 = (const bf16_t*)(P.ws + WS_QC) + qrow * 512 + h * 128; J.q0s = 512;
    J.out = (bf16_t*)(P.ws + WS_OC) + qrow * 512 + h * 128; J.outs = 512;
    attn_job<0, 128, 0, 128, false, CR_PF>(J, smem);
}

#define FOR_DYN(q, total, ci) for (int q = dyn_next((unsigned*)(P.ws + WS_CNT) + (ci)); q < (total); q = dyn_next((unsigned*)(P.ws + WS_CNT) + (ci)))
DI int dyn_next(unsigned* cnt) {
    __shared__ int sjob;
    __syncthreads();
    if (threadIdx.x == 0) sjob = (int)atomicAdd(cnt, 1u);
    __syncthreads();
    return sjob;
}
#define FOR_XJOBS(q, total) for (int it_ = 0, q; (q = ((it_ * 8 + (B & 7)) * (G >> 3)) + (B >> 3)) < (total); ++it_)
DI void run_phase(const Params& P, const int ph, unsigned char* smem, const int rep = 0) {
    const int G = gridDim.x, B = blockIdx.x;
    int tm, tn;
    const bf16_t* W = (const bf16_t*)(P.ws + WS_W);
    if (ph == 0) {
        for (int j = B; j < 18976; j += G) {
            if (j < 6944) prep_weight_tile(P, j, smem);
            else if (j < 11552) prep_x_rows(P, j - 6944);
            else if (j < 11808) prep_mem_rows(P, j - 11552);
            else prep_convert(P, j - 11808);
        }
        return;
    }
    const int l = (ph - 1) / 10, s = (ph - 1) % 10;
    const bf16_t* Wl = W + (size_t)l * W_LAYER;
    if (s == 0) {
        const int extra = (l == 0) ? 128 : 0;
        FOR_XJOBS(j, 2304 + extra) {
            if (j < 2304) { tile_map(j, 16, tm, tn); gemm_tile16<E_PROJ, 2>(P, l, (const bf16_t*)(P.ws + WS_XB), 1024, Wl + W_IN, 1024, tm, tn, smem); }
            else {
                const int jj = j - 2304, ll = jj >> 6, t = jj & 63;
                const bf16_t* Wll = W + (size_t)ll * W_LAYER;
                if (t < 32) gemm_tile<E_MEMK>(P, ll, (const bf16_t*)(P.ws + WS_MEMB), 1024, Wll + W_CK, 1024, t >> 2, t & 3, smem, 0);
                else gemm_tile<E_MEMV>(P, ll, (const bf16_t*)(P.ws + WS_MEMB), 1024, Wll + W_CV, 1024, (t - 32) >> 2, t & 3, smem, 0);
            }
        }
    } else if (s == 1) {
        FOR_XJOBS(j, 1152 + 4608) {
            if (j < 1152) gla_stepA(P, l, j, smem);
            else rowpass(P, l, j - 1152);
        }
        kv_stream(P, l, (const bf16_t*)(P.ws + WS_LATP) + (size_t)l * NPAST * 128, Wl + W_UKV, 0, 8192, smem);
    } else if (s == 2) {
#if REP_MASK & 2048
        FOR_XJOBS(j, 8192) { tile_map(j, 8, tm, tn); gemm_tile<E_KV>(P, l, (const bf16_t*)(P.ws + WS_LATP) + (size_t)l * NPAST * 128, 128, Wl + W_UKV, 128, tm, tn, smem, 1); }
#endif
#if REP_MASK & 4096
        FOR_XJOBS(j, 2016) {
            if (j < 864) { tile_map(j, 6, tm, tn); gemm_tile<E_UQ>(P, l, (const bf16_t*)(P.ws + WS_CQN), 256, Wl + W_UQ, 256, tm, tn, smem, 0); }
            else { tile_map(j - 864, 8, tm, tn); gemm_tile<E_KV>(P, l, (const bf16_t*)(P.ws + WS_LATB), 128, Wl + W_UKV, 128, tm, tn, smem, 0); }
        }
#endif
        FOR_XJOBS(j, 144 + 864 + 1152) {
            if (j < 144) gla_stepB(P, l, j);
            else if (j < 1008) { tile_map(j - 144, 6, tm, tn); gemm_tile<E_UQ>(P, l, (const bf16_t*)(P.ws + WS_CQN), 256, Wl + W_UQ, 256, tm, tn, smem, 0); }
            else { tile_map(j - 1008, 8, tm, tn); gemm_tile<E_KV>(P, l, (const bf16_t*)(P.ws + WS_LATB), 128, Wl + W_UKV, 128, tm, tn, smem, 0); }
        }
    } else if (s == 3) {
        if (P.phase_end - P.phase_begin > 1) {
            FOR_DYN(j, 2496, l + 4 * rep) mixer_job(P, l, j, smem);
        } else {
            for (int j = B; j < 2496; j += G) mixer_job(P, l, j, smem);
        }
    } else if (s == 4) {
        FOR_XJOBS(j, 2304) { tile_map(j, 8, tm, tn); gemm_tile16<E_RES, 1>(P, l, (const bf16_t*)(P.ws + WS_MIX), 1024, Wl + W_OUT, 1024, tm, tn, smem); }
    } else if (s == 5) {
        FOR_XJOBS(j, 1152) { tile_map(j, 4, tm, tn); gemm_tile<E_CQ, 1>(P, l, (const bf16_t*)(P.ws + WS_XB), 1024, Wl + W_CQ, 1024, tm, tn, smem, 0); }
    } else if (s == 6) {
        for (int j = B; j < 1152; j += G) cross_job(P, l, j, smem);
    } else if (s == 7) {
        FOR_XJOBS(j, 2304) { tile_map(j, 8, tm, tn); gemm_tile16<E_RES, 1>(P, l, (const bf16_t*)(P.ws + WS_OC), 512, Wl + W_CO, 512, tm, tn, smem); }
    } else if (s == 8) {
        FOR_XJOBS(j, 6336) { tile_map(j, 44, tm, tn); gemm_tile16<E_GU, 2>(P, l, (const bf16_t*)(P.ws + WS_XB), 1024, Wl + W_GU, 1024, tm, tn, smem); }
    } else {
        FOR_XJOBS(j, 2304) { tile_map(j, 8, tm, tn); gemm_tile16<E_RES, 1>(P, l, (const bf16_t*)(P.ws + WS_ACT), 2816, Wl + W_DN, 2816, tm, tn, smem, l == 1); }
    }
}

__global__ void __launch_bounds__(256, 2) mega_kernel(Params P) {
    extern __shared__ __attribute__((aligned(16))) unsigned char smem[];
    __shared__ uint4 xb_words;
    if (threadIdx.x == 0) xb_words = make_uint4(0u, 0u, 0u, 0u);
    __syncthreads();
    const bool multi = P.phase_end - P.phase_begin > 1;
    XcdBarrier xb;
    if (multi) xb = xcd_barrier_post((unsigned*)(P.ws + WS_BAR), (volatile LAS unsigned*)&xb_words);
    else { xb.bar = nullptr; xb.x = 0; xb.st = (volatile LAS unsigned*)&xb_words; }
    if (P.phase_end < 0) cg::this_grid().sync();
    for (int ph = P.phase_begin; ph < P.phase_end; ++ph) {
        run_phase(P, ph, smem);
#if REP_MASK
        if ((ph > 0 && ((REP_MASK >> ((ph - 1) % 10)) & 1)) || (ph == 0 && (REP_MASK & 1024))) { xcd_barrier(xb); run_phase(P, ph, smem, 1); }
#endif
        if (ph + 1 < P.phase_end) xcd_barrier(xb);
    }
}

extern "C" void kernel_launch(void* const* d_in, const int* in_sizes, int n_in, void* d_out, int out_size, void* d_ws, size_t ws_size,
                              hipStream_t stream) {
    static int grid_blocks = 0;
    if (!grid_blocks) {
        hipFuncSetAttribute((const void*)mega_kernel, hipFuncAttributeMaxDynamicSharedMemorySize, SMEM_BYTES);
        int dev = 0, cus = 0, per_cu = 0;
        hipGetDevice(&dev);
        hipDeviceGetAttribute(&cus, hipDeviceAttributeMultiprocessorCount, dev);
        hipOccupancyMaxActiveBlocksPerMultiprocessor(&per_cu, mega_kernel, 256, SMEM_BYTES);
        if (per_cu < 1) per_cu = 1;
        if (per_cu > 2) per_cu = 2;
        grid_blocks = cus * per_cu;
    }
    if (ws_size < WS_END) { fprintf(stderr, "workspace too small: %zu < %zu\n", ws_size, (size_t)WS_END); return; }
    Params p{};
    for (int i = 0; i < 38; ++i) p.in[i] = (const float*)d_in[i];
    p.out = (float*)d_out;
    p.ws = (unsigned char*)d_ws;
#if ONE_LAUNCH
    p.phase_begin = 0; p.phase_end = NPHASE;
    (void)hipMemsetAsync((unsigned char*)d_ws + WS_BAR, 0, WS_END - WS_BAR, stream);
    void* args[] = {&p};
    hipError_t e = hipLaunchCooperativeKernel((const void*)mega_kernel, dim3(grid_blocks), dim3(256), args, SMEM_BYTES, stream);
    if (e != hipSuccess) fprintf(stderr, "cooperative launch failed: %s (grid %d)\n", hipGetErrorString(e), grid_blocks);
#else
    for (int ph = 0; ph < NPHASE; ++ph) {
        p.phase_begin = ph; p.phase_end = ph + 1;
        hipLaunchKernelGGL(mega_kernel, dim3(grid_blocks), dim3(256), SMEM_BYTES, stream, p);
    }
#endif
}
```

```cpp
#include <hip/hip_runtime.h>
#include <hip/hip_cooperative_groups.h>
#include <stdint.h>
#include <stdio.h>
namespace cg = cooperative_groups;

#ifndef REP_MASK
#define REP_MASK 0
#endif
#ifndef SB_PF
#define SB_PF true
#endif
#ifndef CR_PF
#define CR_PF false
#endif
#ifndef ONE_LAUNCH
#define ONE_LAUNCH 1
#endif

typedef unsigned short bf16_t;
typedef short bf16x8 __attribute__((ext_vector_type(8)));
typedef short s16x4 __attribute__((ext_vector_type(4)));
typedef float f32x16 __attribute__((ext_vector_type(16)));
typedef float f32x2 __attribute__((ext_vector_type(2)));
typedef __bf16 bf16x2n __attribute__((ext_vector_type(2)));
#define DI __device__ __forceinline__
#define MFMA32(a, b, c) __builtin_amdgcn_mfma_f32_32x32x16_bf16((a), (b), (c), 0, 0, 0)

constexpr int R_P = 16384, R_S = 2048, R_ALL = 18432;
constexpr int NPAST = 131072;
constexpr float EPS = 1e-6f;
constexpr float LOG2E = 1.4426950408889634f;
constexpr float LN2 = 0.6931471805599453f;

constexpr size_t O_Y = 0;
constexpr size_t O_SBK_P = 18874368;
constexpr size_t O_SBV_P = O_SBK_P + 8388608;
constexpr size_t O_GLA_P = O_SBV_P + 8388608;
constexpr size_t O_LAT_P = O_GLA_P + 65536;
constexpr size_t O_KR_P = O_LAT_P + 4194304;
constexpr size_t O_MEMK_P = O_KR_P + 1048576;
constexpr size_t O_MEMV_P = O_MEMK_P + 1048576;
constexpr size_t O_SBK_S = O_MEMV_P + 1048576;
constexpr size_t O_SBV_S = O_SBK_S + 1048576;
constexpr size_t O_GLA_S = O_SBV_S + 1048576;
constexpr size_t O_LAT_S = O_GLA_S + 524288;
constexpr size_t O_KR_S = O_LAT_S + 524288;

constexpr size_t W_IN = 0;
constexpr size_t W_UQ = W_IN + 2048 * 1024;
constexpr size_t W_UKV = W_UQ + 768 * 256;
constexpr size_t W_OUT = W_UKV + 1024 * 128;
constexpr size_t W_CQ = W_OUT + 1024 * 1024;
constexpr size_t W_CK = W_CQ + 512 * 1024;
constexpr size_t W_CV = W_CK + 512 * 1024;
constexpr size_t W_CO = W_CV + 512 * 1024;
constexpr size_t W_GU = W_CO + 1024 * 512;
constexpr size_t W_DN = W_GU + 5632 * 1024;
constexpr size_t W_LAYER = W_DN + 1024 * 2816;

constexpr size_t al256(size_t x) { return (x + 255) & ~(size_t)255; }
constexpr size_t WS_W = 0;
constexpr size_t WS_XB = al256(WS_W + 2 * W_LAYER * 2);
constexpr size_t WS_SSQ = al256(WS_XB + (size_t)R_ALL * 1024 * 2);
constexpr size_t WS_PROJ = al256(WS_SSQ + (size_t)R_ALL * 16 * 4);
constexpr size_t WS_CQN = al256(WS_PROJ + (size_t)R_ALL * 2048 * 2);
constexpr size_t WS_LATB = al256(WS_CQN + (size_t)R_ALL * 256 * 2);
constexpr size_t WS_KRB = al256(WS_LATB + (size_t)R_ALL * 128 * 2);
constexpr size_t WS_QN = al256(WS_KRB + (size_t)R_ALL * 32 * 2);
constexpr size_t WS_QR = al256(WS_QN + (size_t)R_ALL * 512 * 2);
constexpr size_t WS_KNB = al256(WS_QR + (size_t)R_ALL * 256 * 2);
constexpr size_t WS_VB = al256(WS_KNB + (size_t)R_ALL * 512 * 2);
constexpr size_t WS_MIX = al256(WS_VB + (size_t)R_ALL * 512 * 2);
constexpr size_t WS_QC = al256(WS_MIX + (size_t)R_ALL * 1024 * 2);
constexpr size_t WS_OC = al256(WS_QC + (size_t)R_ALL * 512 * 2);
constexpr size_t WS_ACT = al256(WS_OC + (size_t)R_ALL * 512 * 2);
constexpr size_t WS_MEMB = al256(WS_ACT + (size_t)R_ALL * 2816 * 2);
constexpr size_t WS_MEMKP = al256(WS_MEMB + (size_t)1024 * 1024 * 2);
constexpr size_t WS_MEMVP = al256(WS_MEMKP + (size_t)2 * 1024 * 512 * 2);
constexpr size_t WS_MEMKS = al256(WS_MEMVP + (size_t)2 * 1024 * 512 * 2);
constexpr size_t WS_MEMVS = al256(WS_MEMKS + (size_t)2 * 8192 * 512 * 2);
constexpr size_t WS_LATP = al256(WS_MEMVS + (size_t)2 * 8192 * 512 * 2);
constexpr size_t WS_KRP = al256(WS_LATP + (size_t)2 * NPAST * 128 * 2);
constexpr size_t WS_KNP = al256(WS_KRP + (size_t)2 * NPAST * 32 * 2);
constexpr size_t WS_VP = al256(WS_KNP + (size_t)NPAST * 512 * 2);
constexpr size_t WS_GLAB = al256(WS_VP + (size_t)NPAST * 512 * 2);
constexpr size_t WS_GLOC = al256(WS_GLAB + (size_t)1152 * 2048 * 4);
constexpr size_t WS_GDEC = al256(WS_GLOC + (size_t)1152 * 2048 * 4);
constexpr size_t WS_GST = al256(WS_GDEC + (size_t)1152 * 32 * 4);
constexpr size_t WS_BAR = al256(WS_GST + (size_t)1152 * 2048 * 4);
constexpr size_t WS_CNT = al256(WS_BAR + 3456 * 4);
constexpr size_t WS_END = al256(WS_CNT + 256);

constexpr int SMEM_BYTES = 77824;
constexpr int NPHASE = 21;

struct Params {
    const float* in[38];
    float* out;
    unsigned char* ws;
    int phase_begin, phase_end;
};

__constant__ double ROPE_REV[16] = {0.15915494309189535, 0.08949940160889101, 0.050329212104487035, 0.0283021958306234,
                                    0.015915494309189534, 0.008949940160889102, 0.005032921210448704, 0.00283021958306234,
                                    0.0015915494309189536, 0.0008949940160889102, 0.0005032921210448703, 0.00028302195830623395,
                                    0.00015915494309189535, 8.949940160889102e-05, 5.0329212104487035e-05, 2.8302195830623396e-05};

typedef unsigned u32x4 __attribute__((ext_vector_type(4)));
DI u32x4 gload16_async(const void* p) { u32x4 v; asm volatile("global_load_dwordx4 %0, %1, off" : "=v"(v) : "v"(p) : "memory"); return v; }
DI u32x4 gload16_async_nt(const void* p) { u32x4 v; asm volatile("global_load_dwordx4 %0, %1, off nt" : "=v"(v) : "v"(p) : "memory"); return v; }
DI void wait_vm0() { asm volatile("s_waitcnt vmcnt(0)" ::: "memory"); }
DI int otid() { int t = threadIdx.x; asm volatile("" : "+v"(t)); return t; }
DI float bf2f(bf16_t v) { return __uint_as_float(((unsigned)v) << 16); }
DI unsigned pack2(float a, float b) { f32x2 v = {a, b}; bf16x2n r = __builtin_convertvector(v, bf16x2n); return __builtin_bit_cast(unsigned, r); }
DI float lo16(unsigned u) { return __uint_as_float(u << 16); }
DI float hi16(unsigned u) { return __uint_as_float(u & 0xffff0000u); }
DI float wave_sum(float v) {
#pragma unroll
    for (int o = 32; o; o >>= 1) v += __shfl_xor(v, o);
    return v;
}
DI int crow(int i, int h) { return (i & 3) + 8 * (i >> 2) + 4 * h; }
DI void tile_map(const int q, const int NTN, int& tm, int& tn) { const int per = 8 * NTN; const int grp = q / per, rem = q - grp * per; tn = rem >> 3; tm = grp * 8 + (rem & 7); }
DI void rope_cs(int pos, int f, float& c, float& s) {
    double rev = (double)pos * ROPE_REV[f];
    rev -= rint(rev);
    float fr = (float)rev;
    c = __builtin_amdgcn_cosf(fr);
    s = __builtin_amdgcn_sinf(fr);
}
DI int row_pos(int row) { return row < R_P ? (row & 4095) : 4096 + ((row - R_P) & 63); }
DI float silu(float x) { return x * __builtin_amdgcn_rcpf(1.f + __builtin_amdgcn_exp2f(-x * LOG2E)); }
DI uint4 cvt8(const float* p) {
    float4 a = *(const float4*)p, b = *(const float4*)(p + 4);
    uint4 r; r.x = pack2(a.x, a.y); r.y = pack2(a.z, a.w); r.z = pack2(b.x, b.y); r.w = pack2(b.z, b.w); return r;
}


#define XB_TMO      128
#define XB_XCNT(j)  (256  + 64 * (j))
#define XB_XSUB(j)  (1280 + 64 * (j))
#define XB_XGEN(j)  (2304 + 64 * (j))
#define XB_TOP      3328
#define XB_TOPGEN   3392
#define XCD_BAR_WORDS 3456
#define XB_SPIN_CAP (1u << 20)
#define LAS __attribute__((address_space(3)))
DI unsigned xb_ld(unsigned* p) { return __hip_atomic_load(p, __ATOMIC_RELAXED, __HIP_MEMORY_SCOPE_AGENT); }
DI unsigned xb_add(unsigned* p, unsigned v) { return __hip_atomic_fetch_add(p, v, __ATOMIC_RELAXED, __HIP_MEMORY_SCOPE_AGENT); }
DI unsigned xb_xcc_id() { return (unsigned)__builtin_amdgcn_s_getreg((3 << 11) | 20) & 0xFu; }
#define XB_SPIN(cond, bar) do { unsigned _sp = 0; while (cond) { __builtin_amdgcn_s_sleep(1); \
    if ((++_sp & 255u) == 0u) { if (xb_ld(&(bar)[XB_TMO])) break; if (_sp > XB_SPIN_CAP) { atomicAdd(&(bar)[XB_TMO], 1u); break; } } } } while (0)
struct XcdBarrier { unsigned* bar; unsigned x; volatile LAS unsigned* st; };
DI XcdBarrier xcd_barrier_post(unsigned* bar, volatile LAS unsigned* st) {
    XcdBarrier b; b.bar = bar; b.x = xb_xcc_id(); b.st = st;
    if (threadIdx.x == 0) (void)xb_add(&bar[XB_XCNT(b.x)], 1u);
    return b;
}
DI void xcd_barrier_complete(unsigned* bar, unsigned x, unsigned& nloc, unsigned& nx) {
    const unsigned G = gridDim.x * gridDim.y * gridDim.z;
    unsigned sum, cnt, mine, sp = 0u;
    for (;;) {
        sum = 0u; cnt = 0u; mine = 0u;
#pragma unroll
        for (unsigned j = 0; j < 16; ++j) { const unsigned c = xb_ld(&bar[XB_XCNT(j)]); sum += c; cnt += (c > 0u) ? 1u : 0u; mine = (j == x) ? c : mine; }
        if (sum == G) break;
        __builtin_amdgcn_s_sleep(1);
        if ((++sp & 255u) == 0u) { if (xb_ld(&bar[XB_TMO])) break; if (sp > XB_SPIN_CAP) { atomicAdd(&bar[XB_TMO], 1u); break; } }
    }
    nloc = mine > 0u ? mine : 1u; nx = cnt > 0u ? cnt : 1u;
}
DI void xcd_barrier(const XcdBarrier& b) {
    asm volatile("s_waitcnt vmcnt(0)" ::: "memory");
    __syncthreads();
    if (threadIdx.x == 0) {
        unsigned* bar = b.bar;
        __builtin_amdgcn_s_waitcnt(0);
        unsigned nloc = b.st[0], nx = b.st[1];
        if (nloc == 0u) { xcd_barrier_complete(bar, b.x, nloc, nx); b.st[0] = nloc; b.st[1] = nx; }
        const unsigned old = xb_add(&bar[XB_XSUB(b.x)], 1u);
        const unsigned gen = old / nloc;
        if (old + 1u == (gen + 1u) * nloc) {
            __builtin_amdgcn_fence(__ATOMIC_RELEASE, "agent");
            asm volatile("s_waitcnt vmcnt(0)" ::: "memory");
            const unsigned og = xb_add(&bar[XB_TOP], 1u);
            const unsigned tg = og / nx;
            if (og + 1u == (tg + 1u) * nx) xb_add(&bar[XB_TOPGEN], 1u);
            else XB_SPIN(xb_ld(&bar[XB_TOPGEN]) == tg, bar);
            __builtin_amdgcn_fence(__ATOMIC_ACQUIRE, "agent");
            xb_add(&bar[XB_XGEN(b.x)], 1u);
            asm volatile("s_waitcnt vmcnt(0)" ::: "memory");
        } else {
            XB_SPIN(xb_ld(&bar[XB_XGEN(b.x)]) == gen, bar);
            __builtin_amdgcn_fence(__ATOMIC_ACQUIRE, "agent");
            asm volatile("s_waitcnt vmcnt(0)" ::: "memory");
        }
    }
    __syncthreads();
}

DI void prep_weight_tile(const Params& P, int j, unsigned char* smem) {
    float* tile = (float*)smem;
    const int l = j / 3472; int t = j % 3472;
    int wid, KT, ldsrc; size_t woff; const float* src; const float* src2 = nullptr; const float* gain = nullptr; int Kd;
    if (t < 512) { wid = 0; KT = 16; ldsrc = 1968; woff = W_IN; src = P.in[11] + (size_t)l * 1024 * 1968; gain = P.in[10] + l * 1024; Kd = 1024; }
    else if (t < 560) { t -= 512; wid = 1; KT = 4; ldsrc = 768; woff = W_UQ; src = P.in[17] + (size_t)l * 256 * 768; gain = P.in[16] + l * 256; Kd = 256; }
    else if (t < 592) { t -= 560; wid = 2; KT = 2; ldsrc = 1024; woff = W_UKV; src = P.in[22] + (size_t)l * 128 * 1024; Kd = 128; }
    else if (t < 848) { t -= 592; wid = 3; KT = 16; ldsrc = 1024; woff = W_OUT; src = P.in[25] + (size_t)l * 1024 * 1024; Kd = 1024; }
    else if (t < 976) { t -= 848; wid = 4; KT = 16; ldsrc = 512; woff = W_CQ; src = P.in[28] + (size_t)l * 1024 * 512; gain = P.in[26] + l * 1024; Kd = 1024; }
    else if (t < 1104) { t -= 976; wid = 5; KT = 16; ldsrc = 512; woff = W_CK; src = P.in[29] + (size_t)l * 1024 * 512; gain = P.in[27] + l * 1024; Kd = 1024; }
    else if (t < 1232) { t -= 1104; wid = 6; KT = 16; ldsrc = 512; woff = W_CV; src = P.in[30] + (size_t)l * 1024 * 512; gain = P.in[27] + l * 1024; Kd = 1024; }
    else if (t < 1360) { t -= 1232; wid = 7; KT = 8; ldsrc = 1024; woff = W_CO; src = P.in[33] + (size_t)l * 512 * 1024; Kd = 512; }
    else if (t < 2768) { t -= 1360; wid = 8; KT = 16; ldsrc = 2816; woff = W_GU; src = P.in[35] + (size_t)l * 1024 * 2816; src2 = P.in[36] + (size_t)l * 1024 * 2816; gain = P.in[34] + l * 1024; Kd = 1024; }
    else { t -= 2768; wid = 9; KT = 44; ldsrc = 1024; woff = W_DN; src = P.in[37] + (size_t)l * 2816 * 1024; Kd = 2816; }
    const int nt = t / KT, kt = t % KT;
    const int n0 = nt * 64, k0 = kt * 64;
    const int tid = otid();
    {
        const int tx = tid & 63, ty = tid >> 6;
        const int n = n0 + tx;
        int sc = n; const float* s = src;
        if (wid == 0) { sc = n < 1280 ? n : (n < 1952 ? n + 16 : (n < 1968 ? n - 672 : -1)); }
        else if (wid == 1) { if (n < 512) sc = (n >> 6) * 96 + (n & 63); else { int c = n - 512; sc = (c >> 5) * 96 + 64 + (c & 31); } }
        else if (wid == 2) { if (n < 512) sc = (n >> 6) * 128 + (n & 63); else { int c = n - 512; sc = (c >> 6) * 128 + 64 + (c & 63); } }
        else if (wid == 8) { int blk = n >> 6, w = n & 63; sc = blk * 32 + (w & 31); if (w >= 32) s = src2; }
        float vals[16];
#pragma unroll
        for (int i = 0; i < 16; ++i) {
            const int kk = ty + 4 * i;
            vals[i] = (sc >= 0) ? s[(size_t)(k0 + kk) * ldsrc + sc] : 0.f;
        }
        if (gain) {
#pragma unroll
            for (int i = 0; i < 16; ++i) vals[i] *= gain[k0 + ty + 4 * i];
        }
#pragma unroll
        for (int i = 0; i < 16; ++i) tile[(ty + 4 * i) * 65 + tx] = vals[i];
    }
    __syncthreads();
    {
        bf16_t* Wt = (bf16_t*)(P.ws + WS_W) + (size_t)l * W_LAYER + woff;
        const int tx = tid & 31, ty = tid >> 5;
#pragma unroll
        for (int nn = ty; nn < 64; nn += 8) {
            unsigned v = pack2(tile[(2 * tx) * 65 + nn], tile[(2 * tx + 1) * 65 + nn]);
            *(unsigned*)(Wt + (size_t)(n0 + nn) * Kd + k0 + 2 * tx) = v;
        }
    }
    __syncthreads();
}

DI void prep_x_rows(const Params& P, int j) {
    const int tid_ = otid(); const int lane = tid_ & 63, wave = tid_ >> 6;
    const int row = j * 4 + wave;
    const float* src = row < R_P ? P.in[0] + (size_t)row * 1024 : P.in[1] + (size_t)(row - R_P) * 1024;
    float* y = P.out + O_Y + (size_t)row * 1024;
    bf16_t* xb = (bf16_t*)(P.ws + WS_XB) + (size_t)row * 1024;
    float ss = 0.f;
#pragma unroll
    for (int i = 0; i < 4; ++i) {
        const int c = i * 256 + lane * 4;
        float4 v = *(const float4*)(src + c);
        *(float4*)(y + c) = v;
        uint2 b; b.x = pack2(v.x, v.y); b.y = pack2(v.z, v.w);
        *(uint2*)(xb + c) = b;
        ss += v.x * v.x + v.y * v.y + v.z * v.z + v.w * v.w;
    }
    ss = wave_sum(ss);
    float* sq = (float*)(P.ws + WS_SSQ) + (size_t)row * 16;
    if (lane < 16) sq[lane] = lane == 0 ? ss : 0.f;
}
DI void prep_mem_rows(const Params& P, int j) {
    const int tid_ = otid(); const int lane = tid_ & 63, wave = tid_ >> 6;
    const int row = j * 4 + wave;
    const float* src = P.in[2] + (size_t)row * 1024;
    bf16_t* mb = (bf16_t*)(P.ws + WS_MEMB) + (size_t)row * 1024;
    float4 v[4]; float ss = 0.f;
#pragma unroll
    for (int i = 0; i < 4; ++i) { v[i] = *(const float4*)(src + i * 256 + lane * 4); ss += v[i].x * v[i].x + v[i].y * v[i].y + v[i].z * v[i].z + v[i].w * v[i].w; }
    ss = wave_sum(ss);
    const float rinv = __builtin_amdgcn_rsqf(ss * (1.f / 1024.f) + EPS);
#pragma unroll
    for (int i = 0; i < 4; ++i) { uint2 b; b.x = pack2(v[i].x * rinv, v[i].y * rinv); b.y = pack2(v[i].z * rinv, v[i].w * rinv); *(uint2*)(mb + i * 256 + lane * 4) = b; }
}
DI void prep_convert(const Params& P, int j) {
    const float* src; bf16_t* dst; size_t off;
    if (j < 4096) { src = P.in[6]; dst = (bf16_t*)(P.ws + WS_LATP); off = (size_t)j * 8192; }
    else if (j < 5120) { src = P.in[7]; dst = (bf16_t*)(P.ws + WS_KRP); off = (size_t)(j - 4096) * 8192; }
    else if (j < 6144) { src = P.in[8]; dst = (bf16_t*)(P.ws + WS_MEMKS); off = (size_t)(j - 5120) * 8192; }
    else { src = P.in[9]; dst = (bf16_t*)(P.ws + WS_MEMVS); off = (size_t)(j - 6144) * 8192; }
    off += otid() * 8;
    float4 a[4], b[4];
#pragma unroll
    for (int i = 0; i < 4; ++i) { a[i] = *(const float4*)(src + off + i * 2048); b[i] = *(const float4*)(src + off + i * 2048 + 4); }
#pragma unroll
    for (int i = 0; i < 4; ++i) { uint4 r; r.x = pack2(a[i].x, a[i].y); r.y = pack2(a[i].z, a[i].w); r.z = pack2(b[i].x, b[i].y); r.w = pack2(b[i].z, b[i].w); *(uint4*)(dst + off + i * 2048) = r; }
}

enum { E_PROJ = 0, E_UQ, E_KV, E_RES, E_CQ, E_MEMK, E_MEMV, E_GU };

template <int EPI, int MT = 2>
DI void gemm_tile(const Params& P, const int l, const bf16_t* __restrict__ A, const int lda, const bf16_t* __restrict__ Bt, const int K,
                  const int tm, const int tn, unsigned char* smem, const int variant) {
    const int tid = otid(), lane = tid & 63, wave = tid >> 6, r = lane & 31, h = lane >> 5;
    const int wm = wave & 1, wn = wave >> 1;
    const bf16_t* Ag = A + (size_t)(tm * (64 * MT)) * lda;
    const bf16_t* Bg = Bt + (size_t)(tn * 128) * K;
    const int lrow = tid >> 3, lcc = tid & 7;
    f32x16 acc[2][MT];
#pragma unroll
    for (int a = 0; a < 2; ++a)
#pragma unroll
        for (int b = 0; b < MT; ++b)
#pragma unroll
            for (int i = 0; i < 16; ++i) acc[a][b][i] = 0.f;
    const int nk = K >> 6;
    constexpr int STGB = (64 * MT + 128) * 128;
    constexpr int BOFF = 64 * MT * 128;
    const int xr = (r >> 1) & 7;
    const int srow = lane >> 3;
    const int spos = lane & 7;
#define GLDS_ISSUE(STG, KT) { const int k0_ = (KT) * 64; unsigned char* sb_ = smem + (STG) * STGB; \
        _Pragma("unroll") for (int i = 0; i < 2 * MT; ++i) { const int blk = i * 4 + wave; const int row = blk * 8 + srow; const int c = spos ^ ((row >> 1) & 7); \
            __builtin_amdgcn_global_load_lds((const unsigned*)(Ag + (size_t)row * lda + k0_ + c * 8), (unsigned*)(sb_ + blk * 1024 + lane * 16), 16, 0, 0); } \
        _Pragma("unroll") for (int i = 0; i < 4; ++i) { const int blk = i * 4 + wave; const int row = blk * 8 + srow; const int c = spos ^ ((row >> 1) & 7); \
            __builtin_amdgcn_global_load_lds((const unsigned*)(Bg + (size_t)row * K + k0_ + c * 8), (unsigned*)(sb_ + BOFF + blk * 1024 + lane * 16), 16, 0, 0); } }
#define GLDS_FR(FS, STG, KS) { const unsigned char* cur = smem + (STG) * STGB; const int co = (((2 * (KS) + h) ^ xr) * 16); \
        _Pragma("unroll") for (int nt = 0; nt < 2; ++nt) bfr[FS][nt] = *(const bf16x8*)(cur + BOFF + (wn * 64 + 32 * nt + r) * 128 + co); \
        _Pragma("unroll") for (int mt = 0; mt < MT; ++mt) afr[FS][mt] = *(const bf16x8*)(cur + (wm * (32 * MT) + 32 * mt + r) * 128 + co); }
#define GEMM_MM(FS) { _Pragma("unroll") for (int nt = 0; nt < 2; ++nt) _Pragma("unroll") for (int mt = 0; mt < MT; ++mt) acc[nt][mt] = MFMA32(bfr[FS][nt], afr[FS][mt], acc[nt][mt]); }
    bf16x8 bfr[2][2], afr[2][MT];
    GLDS_ISSUE(0, 0);
    __syncthreads();
    for (int kt = 0; kt < nk; ++kt) {
        const int st = kt & 1;
        if (kt + 1 < nk) GLDS_ISSUE(st ^ 1, kt + 1);
        GLDS_FR(0, st, 0);
        GLDS_FR(1, st, 1); GEMM_MM(0);
        GLDS_FR(0, st, 2); GEMM_MM(1);
        GLDS_FR(1, st, 3); GEMM_MM(0);
        GEMM_MM(1);
        __syncthreads();
    }
#undef GLDS_ISSUE
#undef GLDS_FR
#undef GEMM_MM
    const int rowb = tm * (64 * MT) + wm * (32 * MT) + r;
    const int colb = tn * 128 + wn * 64 + 4 * h;
    float rinv[MT];
#pragma unroll
    for (int mt = 0; mt < MT; ++mt) rinv[mt] = 1.f;
    if (EPI == E_PROJ || EPI == E_CQ || EPI == E_GU) {
        const float* sq = (const float*)(P.ws + WS_SSQ);
#pragma unroll
        for (int mt = 0; mt < MT; ++mt) {
            const float4* p4 = (const float4*)(sq + (size_t)(rowb + 32 * mt) * 16);
            float4 a = p4[0], b = p4[1], c = p4[2], d = p4[3];
            float s = (a.x + a.y + a.z + a.w) + (b.x + b.y + b.z + b.w) + (c.x + c.y + c.z + c.w) + (d.x + d.y + d.z + d.w);
            rinv[mt] = __builtin_amdgcn_rsqf(s * (1.f / 1024.f) + EPS);
        }
    }
    if (EPI == E_PROJ) {
        bf16_t* pb = (bf16_t*)(P.ws + WS_PROJ);
        const bool kv = (tn >= 2 && tn < 6);
#pragma unroll
        for (int mt = 0; mt < MT; ++mt) {
            const int row = rowb + 32 * mt;
            float* fo = nullptr;
            if (kv) {
                const int isv = tn >= 4;
                if (row < R_P) fo = P.out + (isv ? O_SBV_P : O_SBK_P) + ((size_t)l * R_P + row) * 256;
                else fo = P.out + (isv ? O_SBV_S : O_SBK_S) + ((size_t)l * R_S + (row - R_P)) * 256;
                fo -= isv ? 512 : 256;
            }
#pragma unroll
            for (int nt = 0; nt < 2; ++nt)
#pragma unroll
                for (int g = 0; g < 4; ++g) {
                    const int col = colb + 32 * nt + 8 * g;
                    float v0 = acc[nt][mt][4 * g] * rinv[mt], v1 = acc[nt][mt][4 * g + 1] * rinv[mt], v2 = acc[nt][mt][4 * g + 2] * rinv[mt], v3 = acc[nt][mt][4 * g + 3] * rinv[mt];
                    uint2 b; b.x = pack2(v0, v1); b.y = pack2(v2, v3);
                    *(uint2*)(smem + (wm * (32 * MT) + 32 * mt + r) * 272 + (wn * 64 + 32 * nt + 8 * g + 4 * h) * 2) = b;
                    if (kv) *(float4*)(fo + col) = make_float4(v0, v1, v2, v3);
                }
        }
        __syncthreads();
#pragma unroll
        for (int it = 0; it < 4 * MT; ++it) {
            const int row = it * 16 + (tid >> 4), cc = tid & 15;
            const u32x4 v = *(const u32x4*)(smem + row * 272 + cc * 16);
            *(u32x4*)(pb + (size_t)(tm * (64 * MT) + row) * 2048 + tn * 128 + cc * 8) = v;
        }
        __syncthreads();
    } else if (EPI == E_UQ) {
        if (tn < 4) {
            bf16_t* qn = (bf16_t*)(P.ws + WS_QN);
            const float* g_qn = P.in[18] + l * 64;
            const float SC = 0.10206207261596575f * LOG2E;
            float4 ggq[2][4];
#pragma unroll
            for (int nt = 0; nt < 2; ++nt)
#pragma unroll
                for (int g = 0; g < 4; ++g) ggq[nt][g] = *(const float4*)(g_qn + 32 * nt + 8 * g + 4 * h);
#pragma unroll
            for (int mt = 0; mt < MT; ++mt) {
                const int row = rowb + 32 * mt;
                float ss = 0.f;
#pragma unroll
                for (int nt = 0; nt < 2; ++nt)
#pragma unroll
                    for (int i = 0; i < 16; ++i) ss += acc[nt][mt][i] * acc[nt][mt][i];
                ss += __shfl_xor(ss, 32);
                const float ri = __builtin_amdgcn_rsqf(ss * (1.f / 64.f) + EPS) * SC;
#pragma unroll
                for (int nt = 0; nt < 2; ++nt)
#pragma unroll
                    for (int g = 0; g < 4; ++g) {
                        const int d = 32 * nt + 8 * g + 4 * h;
                        const float4 gg = ggq[nt][g];
                        uint2 b; b.x = pack2(acc[nt][mt][4 * g] * ri * gg.x, acc[nt][mt][4 * g + 1] * ri * gg.y);
                        b.y = pack2(acc[nt][mt][4 * g + 2] * ri * gg.z, acc[nt][mt][4 * g + 3] * ri * gg.w);
                        *(uint2*)(qn + (size_t)row * 512 + tn * 128 + wn * 64 + d) = b;
                    }
            }
        } else {
            bf16_t* qr = (bf16_t*)(P.ws + WS_QR);
            const float* g_qr = P.in[19] + l * 32;
            const float SC = 0.10206207261596575f * LOG2E;
            float gqr[16];
#pragma unroll
            for (int i = 0; i < 16; ++i) gqr[i] = g_qr[crow(i, h)];
#pragma unroll
            for (int mt = 0; mt < MT; ++mt) {
                const int row = rowb + 32 * mt;
                const int pos = row_pos(row);
                float cs[8], sn[8];
#pragma unroll
                for (int i = 0; i < 8; ++i) rope_cs(pos, crow(i, h), cs[i], sn[i]);
#pragma unroll
                for (int nt = 0; nt < 2; ++nt) {
                    float ss = 0.f;
#pragma unroll
                    for (int i = 0; i < 16; ++i) ss += acc[nt][mt][i] * acc[nt][mt][i];
                    ss += __shfl_xor(ss, 32);
                    const float ri = __builtin_amdgcn_rsqf(ss * (1.f / 32.f) + EPS);
                    float y[16];
#pragma unroll
                    for (int i = 0; i < 16; ++i) y[i] = acc[nt][mt][i] * ri * gqr[i];
                    float o[16];
#pragma unroll
                    for (int i = 0; i < 8; ++i) { o[i] = (y[i] * cs[i] - y[i + 8] * sn[i]) * SC; o[i + 8] = (y[i] * sn[i] + y[i + 8] * cs[i]) * SC; }
                    const int cb = (tn - 4) * 128 + wn * 64 + 32 * nt;
#pragma unroll
                    for (int g = 0; g < 4; ++g) {
                        uint2 b; b.x = pack2(o[4 * g], o[4 * g + 1]); b.y = pack2(o[4 * g + 2], o[4 * g + 3]);
                        *(uint2*)(qr + (size_t)row * 256 + cb + 8 * g + 4 * h) = b;
                    }
                }
            }
        }
    } else if (EPI == E_KV) {
        bf16_t* dst = (bf16_t*)(P.ws + (tn < 4 ? (variant ? WS_KNP : WS_KNB) : (variant ? WS_VP : WS_VB)));
        const int dcol0 = (tn & 3) * 128;
        const float* g_kn = P.in[23] + l * 64;
#pragma unroll
        for (int mt = 0; mt < MT; ++mt) {
            float ri = 1.f;
            if (tn < 4) {
                float ss = 0.f;
#pragma unroll
                for (int nt = 0; nt < 2; ++nt)
#pragma unroll
                    for (int i = 0; i < 16; ++i) ss += acc[nt][mt][i] * acc[nt][mt][i];
                ss += __shfl_xor(ss, 32);
                ri = __builtin_amdgcn_rsqf(ss * (1.f / 64.f) + EPS);
            }
#pragma unroll
            for (int nt = 0; nt < 2; ++nt)
#pragma unroll
                for (int g = 0; g < 4; ++g) {
                    const int d = 32 * nt + 8 * g + 4 * h;
                    float4 gg = make_float4(1.f, 1.f, 1.f, 1.f);
                    if (tn < 4) gg = *(const float4*)(g_kn + d);
                    uint2 b; b.x = pack2(acc[nt][mt][4 * g] * ri * gg.x, acc[nt][mt][4 * g + 1] * ri * gg.y);
                    b.y = pack2(acc[nt][mt][4 * g + 2] * ri * gg.z, acc[nt][mt][4 * g + 3] * ri * gg.w);
                    *(uint2*)(smem + (wm * (32 * MT) + 32 * mt + r) * 272 + (wn * 64 + d) * 2) = b;
                }
        }
        __syncthreads();
#pragma unroll
        for (int it = 0; it < 4 * MT; ++it) {
            const int row = it * 16 + (tid >> 4), cc = tid & 15;
            const u32x4 v = *(const u32x4*)(smem + row * 272 + cc * 16);
            *(u32x4*)(dst + (size_t)(tm * (64 * MT) + row) * 512 + dcol0 + cc * 8) = v;
        }
        __syncthreads();
    } else if (EPI == E_RES) {
        float* x = P.out + O_Y;
        bf16_t* xb = (bf16_t*)(P.ws + WS_XB);
        float* sq = (float*)(P.ws + WS_SSQ);
        float* stg = (float*)smem;
#pragma unroll
        for (int nt = 0; nt < 2; ++nt)
#pragma unroll
            for (int g = 0; g < 4; ++g)
                *(float4*)(stg + (wm * 32 + r) * 132 + wn * 64 + 32 * nt + 8 * g + 4 * h) = make_float4(acc[nt][0][4 * g], acc[nt][0][4 * g + 1], acc[nt][0][4 * g + 2], acc[nt][0][4 * g + 3]);
        __syncthreads();
        const int l32 = tid & 31, rsub = tid >> 5;
        const int col = tn * 128 + l32 * 4;
        float4 xin[8];
#pragma unroll
        for (int it = 0; it < 8; ++it) xin[it] = *(const float4*)(x + ((size_t)tm * 64 + it * 8 + rsub) * 1024 + col);
#pragma unroll
        for (int it = 0; it < 8; ++it) {
            const int rl = it * 8 + rsub;
            const size_t row = (size_t)tm * 64 + rl;
            const float4 a = *(const float4*)(stg + rl * 132 + l32 * 4);
            float4 xo = xin[it];
            xo.x += a.x; xo.y += a.y; xo.z += a.z; xo.w += a.w;
            *(float4*)(x + row * 1024 + col) = xo;
            uint2 bb; bb.x = pack2(xo.x, xo.y); bb.y = pack2(xo.z, xo.w);
            *(uint2*)(xb + row * 1024 + col) = bb;
            float ss = xo.x * xo.x + xo.y * xo.y + xo.z * xo.z + xo.w * xo.w;
            ss += __shfl_xor(ss, 16); ss += __shfl_xor(ss, 8); ss += __shfl_xor(ss, 4); ss += __shfl_xor(ss, 2); ss += __shfl_xor(ss, 1);
            if (l32 < 2) sq[row * 16 + tn * 2 + l32] = l32 == 0 ? ss : 0.f;
        }
        __syncthreads();
    } else if (EPI == E_CQ || EPI == E_MEMK) {
        float* red = (float*)(smem + 73728);
        float ssl[MT];
#pragma unroll
        for (int mt = 0; mt < MT; ++mt) {
            float ss = 0.f;
#pragma unroll
            for (int nt = 0; nt < 2; ++nt)
#pragma unroll
                for (int i = 0; i < 16; ++i) { float v = acc[nt][mt][i] * rinv[mt]; acc[nt][mt][i] = v; ss += v * v; }
            ss += __shfl_xor(ss, 32);
            ssl[mt] = ss;
            if (h == 0) red[wn * 128 + wm * (32 * MT) + 32 * mt + r] = ss;
        }
        __syncthreads();
        const float* gn = (EPI == E_CQ ? P.in[31] : P.in[32]) + l * 128;
        const float SC = (EPI == E_CQ) ? 0.08838834764831845f * LOG2E : 1.f;
        float4 ggc[2][4];
#pragma unroll
        for (int nt = 0; nt < 2; ++nt)
#pragma unroll
            for (int g = 0; g < 4; ++g) ggc[nt][g] = *(const float4*)(gn + wn * 64 + 32 * nt + 8 * g + 4 * h);
#pragma unroll
        for (int mt = 0; mt < MT; ++mt) {
            const int row = rowb + 32 * mt;
            const float tot = ssl[mt] + red[(wn ^ 1) * 128 + wm * (32 * MT) + 32 * mt + r];
            const float ri = __builtin_amdgcn_rsqf(tot * (1.f / 128.f) + EPS) * SC;
#pragma unroll
            for (int nt = 0; nt < 2; ++nt)
#pragma unroll
                for (int g = 0; g < 4; ++g) {
                    const int d = wn * 64 + 32 * nt + 8 * g + 4 * h;
                    const float4 gg = ggc[nt][g];
                    const float v0 = acc[nt][mt][4 * g] * ri * gg.x, v1 = acc[nt][mt][4 * g + 1] * ri * gg.y, v2 = acc[nt][mt][4 * g + 2] * ri * gg.z, v3 = acc[nt][mt][4 * g + 3] * ri * gg.w;
                    uint2 b; b.x = pack2(v0, v1); b.y = pack2(v2, v3);
                    if (EPI == E_CQ) {
                        *(uint2*)((bf16_t*)(P.ws + WS_QC) + (size_t)row * 512 + tn * 128 + d) = b;
                    } else {
                        *(uint2*)((bf16_t*)(P.ws + WS_MEMKP) + ((size_t)l * 1024 + row) * 512 + tn * 128 + d) = b;
                        *(float4*)(P.out + O_MEMK_P + ((size_t)l * 1024 + row) * 512 + tn * 128 + d) = make_float4(v0, v1, v2, v3);
                    }
                }
        }
        __syncthreads();
    } else if (EPI == E_MEMV) {
#pragma unroll
        for (int mt = 0; mt < MT; ++mt) {
            const int row = rowb + 32 * mt;
#pragma unroll
            for (int nt = 0; nt < 2; ++nt)
#pragma unroll
                for (int g = 0; g < 4; ++g) {
                    const int col = colb + 32 * nt + 8 * g;
                    uint2 b; b.x = pack2(acc[nt][mt][4 * g], acc[nt][mt][4 * g + 1]); b.y = pack2(acc[nt][mt][4 * g + 2], acc[nt][mt][4 * g + 3]);
                    *(uint2*)((bf16_t*)(P.ws + WS_MEMVP) + ((size_t)l * 1024 + row) * 512 + col) = b;
                    *(float4*)(P.out + O_MEMV_P + ((size_t)l * 1024 + row) * 512 + col) = make_float4(acc[nt][mt][4 * g], acc[nt][mt][4 * g + 1], acc[nt][mt][4 * g + 2], acc[nt][mt][4 * g + 3]);
                }
        }
    } else if (EPI == E_GU) {
        bf16_t* act = (bf16_t*)(P.ws + WS_ACT);
#pragma unroll
        for (int mt = 0; mt < MT; ++mt) {
#pragma unroll
            for (int g = 0; g < 4; ++g) {
                float o[4];
#pragma unroll
                for (int e = 0; e < 4; ++e) { const float gt = acc[0][mt][4 * g + e] * rinv[mt], up = acc[1][mt][4 * g + e] * rinv[mt]; o[e] = silu(gt) * up; }
                uint2 b; b.x = pack2(o[0], o[1]); b.y = pack2(o[2], o[3]);
                *(uint2*)(smem + (wm * (32 * MT) + 32 * mt + r) * 144 + (wn * 32 + 8 * g + 4 * h) * 2) = b;
            }
        }
        __syncthreads();
#pragma unroll
        for (int it = 0; it < 2 * MT; ++it) {
            const int row = it * 32 + (tid >> 3), cc = tid & 7;
            const u32x4 v = *(const u32x4*)(smem + row * 144 + cc * 16);
            *(u32x4*)(act + (size_t)(tm * (64 * MT) + row) * 2816 + tn * 64 + cc * 8) = v;
        }
        __syncthreads();
    }
}

typedef float f32x4v __attribute__((ext_vector_type(4)));
#define MFMA16(a, b, c) __builtin_amdgcn_mfma_f32_16x16x32_bf16((a), (b), (c), 0, 0, 0)
template <int EPI, int MT>
DI void gemm_tile16(const Params& P, const int l, const bf16_t* __restrict__ A, const int lda, const bf16_t* __restrict__ Bt, const int K,
                    const int tm, const int tn, unsigned char* smem, const bool last_res = false) {
    constexpr int NMT = 2 * MT;
    const int tid = otid(), lane = tid & 63, wave = tid >> 6, i16 = lane & 15, quad = lane >> 4;
    const int wm = wave & 1, wn = wave >> 1;
    const bf16_t* Ag = A + (size_t)(tm * (64 * MT)) * lda;
    const bf16_t* Bg = Bt + (size_t)(tn * 128) * K;
    f32x4v acc[4][NMT];
#pragma unroll
    for (int a = 0; a < 4; ++a)
#pragma unroll
        for (int b = 0; b < NMT; ++b)
#pragma unroll
            for (int i = 0; i < 4; ++i) acc[a][b][i] = 0.f;
    float rinv[NMT];
#pragma unroll
    for (int mt = 0; mt < NMT; ++mt) rinv[mt] = 1.f;
    if (EPI == E_GU || EPI == E_PROJ) {
        const float* sq = (const float*)(P.ws + WS_SSQ);
#pragma unroll
        for (int mt = 0; mt < NMT; ++mt) {
            const float4* p4 = (const float4*)(sq + (size_t)(tm * (64 * MT) + wm * (32 * MT) + 16 * mt + i16) * 16);
            float4 a = p4[0], b = p4[1], c = p4[2], d = p4[3];
            float s = (a.x + a.y + a.z + a.w) + (b.x + b.y + b.z + b.w) + (c.x + c.y + c.z + c.w) + (d.x + d.y + d.z + d.w);
            rinv[mt] = __builtin_amdgcn_rsqf(s * (1.f / 1024.f) + EPS);
        }
    }
    const int nk = K >> 6;
    constexpr int STGB = (64 * MT + 128) * 128;
    constexpr int BOFF = 64 * MT * 128;
    const int xr = (i16 >> 1) & 7;
    const int srow = lane >> 3, spos = lane & 7;
#define G16_ISSUE(STG, KT) { const int k0_ = (KT) * 64; unsigned char* sb_ = smem + (STG) * STGB; \
        _Pragma("unroll") for (int i = 0; i < 2 * MT; ++i) { const int blk = i * 4 + wave; const int row = blk * 8 + srow; const int c = spos ^ ((row >> 1) & 7); \
            __builtin_amdgcn_global_load_lds((const unsigned*)(Ag + (size_t)row * lda + k0_ + c * 8), (unsigned*)(sb_ + blk * 1024 + lane * 16), 16, 0, 0); } \
        _Pragma("unroll") for (int i = 0; i < 4; ++i) { const int blk = i * 4 + wave; const int row = blk * 8 + srow; const int c = spos ^ ((row >> 1) & 7); \
            __builtin_amdgcn_global_load_lds((const unsigned*)(Bg + (size_t)row * K + k0_ + c * 8), (unsigned*)(sb_ + BOFF + blk * 1024 + lane * 16), 16, 0, 0); } }
#define G16_FR(FS, STG, KS) { const unsigned char* cur = smem + (STG) * STGB; const int co = (((4 * (KS) + quad) ^ xr) * 16); \
        _Pragma("unroll") for (int nt = 0; nt < 4; ++nt) wfr[FS][nt] = *(const bf16x8*)(cur + BOFF + (wn * 64 + 16 * nt + i16) * 128 + co); \
        _Pragma("unroll") for (int mt = 0; mt < NMT; ++mt) xfr[FS][mt] = *(const bf16x8*)(cur + (wm * (32 * MT) + 16 * mt + i16) * 128 + co); }
#define G16_MM(FS) { _Pragma("unroll") for (int nt = 0; nt < 4; ++nt) _Pragma("unroll") for (int mt = 0; mt < NMT; ++mt) acc[nt][mt] = MFMA16(wfr[FS][nt], xfr[FS][mt], acc[nt][mt]); }
    bf16x8 wfr[2][4], xfr[2][NMT];
    G16_ISSUE(0, 0);
    __syncthreads();
    for (int kt = 0; kt < nk; ++kt) {
        const int st = kt & 1;
        if (kt + 1 < nk) G16_ISSUE(st ^ 1, kt + 1);
        G16_FR(0, st, 0);
        G16_FR(1, st, 1); G16_MM(0);
        G16_MM(1);
        __syncthreads();
    }
#undef G16_ISSUE
#undef G16_FR
#undef G16_MM
    if (EPI == E_GU) {
        bf16_t* act = (bf16_t*)(P.ws + WS_ACT);
#pragma unroll
        for (int mt = 0; mt < NMT; ++mt)
#pragma unroll
            for (int nt = 0; nt < 2; ++nt) {
                float o[4];
#pragma unroll
                for (int e = 0; e < 4; ++e) { const float gt = acc[nt][mt][e] * rinv[mt], up = acc[nt + 2][mt][e] * rinv[mt]; o[e] = silu(gt) * up; }
                uint2 b; b.x = pack2(o[0], o[1]); b.y = pack2(o[2], o[3]);
                *(uint2*)(smem + (wm * (32 * MT) + 16 * mt + i16) * 144 + (wn * 32 + 16 * nt + 4 * quad) * 2) = b;
            }
        __syncthreads();
#pragma unroll
        for (int it = 0; it < 2 * MT; ++it) {
            const int row = it * 32 + (tid >> 3), cc = tid & 7;
            const u32x4 v = *(const u32x4*)(smem + row * 144 + cc * 16);
            *(u32x4*)(act + (size_t)(tm * (64 * MT) + row) * 2816 + tn * 64 + cc * 8) = v;
        }
        __syncthreads();
    } else if (EPI == E_PROJ) {
        bf16_t* pb = (bf16_t*)(P.ws + WS_PROJ);
        const bool kv = (tn >= 2 && tn < 6);
#pragma unroll
        for (int mt = 0; mt < NMT; ++mt) {
            const int rl = wm * (32 * MT) + 16 * mt + i16;
            const int row = tm * (64 * MT) + rl;
            float* fo = nullptr;
            if (kv) {
                const int isv = tn >= 4;
                if (row < R_P) fo = P.out + (isv ? O_SBV_P : O_SBK_P) + ((size_t)l * R_P + row) * 256;
                else fo = P.out + (isv ? O_SBV_S : O_SBK_S) + ((size_t)l * R_S + (row - R_P)) * 256;
                fo -= isv ? 512 : 256;
            }
#pragma unroll
            for (int nt = 0; nt < 4; ++nt) {
                const int cl = wn * 64 + 16 * nt + 4 * quad;
                const float v0 = acc[nt][mt][0] * rinv[mt], v1 = acc[nt][mt][1] * rinv[mt], v2 = acc[nt][mt][2] * rinv[mt], v3 = acc[nt][mt][3] * rinv[mt];
                uint2 bb; bb.x = pack2(v0, v1); bb.y = pack2(v2, v3);
                *(uint2*)(smem + rl * 272 + cl * 2) = bb;
                if (kv) *(float4*)(fo + tn * 128 + cl) = make_float4(v0, v1, v2, v3);
            }
        }
        __syncthreads();
#pragma unroll
        for (int it = 0; it < 4 * MT; ++it) {
            const int row = it * 16 + (tid >> 4), cc = tid & 15;
            const u32x4 v = *(const u32x4*)(smem + row * 272 + cc * 16);
            *(u32x4*)(pb + (size_t)(tm * (64 * MT) + row) * 2048 + tn * 128 + cc * 8) = v;
        }
        __syncthreads();
    } else {
        float* x = P.out + O_Y;
        bf16_t* xb = (bf16_t*)(P.ws + WS_XB);
        float* sq = (float*)(P.ws + WS_SSQ);
        float* stg = (float*)smem;
#pragma unroll
        for (int mt = 0; mt < NMT; ++mt)
#pragma unroll
            for (int nt = 0; nt < 4; ++nt)
                *(float4*)(stg + (wm * 32 + 16 * mt + i16) * 132 + wn * 64 + 16 * nt + 4 * quad) = make_float4(acc[nt][mt][0], acc[nt][mt][1], acc[nt][mt][2], acc[nt][mt][3]);
        __syncthreads();
        const int l32 = tid & 31, rsub = tid >> 5;
        const int col = tn * 128 + l32 * 4;
        float4 xin[8];
#pragma unroll
        for (int it = 0; it < 8; ++it) xin[it] = *(const float4*)(x + ((size_t)tm * 64 + it * 8 + rsub) * 1024 + col);
#pragma unroll
        for (int it = 0; it < 8; ++it) {
            const int rl = it * 8 + rsub;
            const size_t row = (size_t)tm * 64 + rl;
            const float4 a = *(const float4*)(stg + rl * 132 + l32 * 4);
            float4 xo = xin[it];
            xo.x += a.x; xo.y += a.y; xo.z += a.z; xo.w += a.w;
            *(float4*)(x + row * 1024 + col) = xo;
            if (!last_res) {
                uint2 bb; bb.x = pack2(xo.x, xo.y); bb.y = pack2(xo.z, xo.w);
                *(uint2*)(xb + row * 1024 + col) = bb;
                float ss = xo.x * xo.x + xo.y * xo.y + xo.z * xo.z + xo.w * xo.w;
                ss += __shfl_xor(ss, 16); ss += __shfl_xor(ss, 8); ss += __shfl_xor(ss, 4); ss += __shfl_xor(ss, 2); ss += __shfl_xor(ss, 1);
                if (l32 < 2) sq[row * 16 + tn * 2 + l32] = l32 == 0 ? ss : 0.f;
            }
        }
        __syncthreads();
    }
}

DI void kv_stream(const Params& P, const int l, const bf16_t* __restrict__ A, const bf16_t* __restrict__ Bt, const int first, const int count, unsigned char* smem) {
    const int tid = otid(), lane = tid & 63, wave = tid >> 6, r = lane & 31, h = lane >> 5;
    const int wm = wave & 1, wn = wave >> 1;
    const int lrow = tid >> 3, lcc = tid & 7;
    const int G = gridDim.x, B = blockIdx.x;
    const float* g_kn = P.in[23] + l * 64;
    float4 ggk[2][4];
#pragma unroll
    for (int nt = 0; nt < 2; ++nt)
#pragma unroll
        for (int g = 0; g < 4; ++g) ggk[nt][g] = *(const float4*)(g_kn + 32 * nt + 8 * g + 4 * h);
    u32x4 ra[2][4], rb[2][4];
    int tm, tn;
#define KVS_ISSUE(Q) { int tm_, tn_; tile_map(first + (Q), 8, tm_, tn_); const bf16_t* Ag = A + (size_t)(tm_ * 128) * 128; const bf16_t* Bg = Bt + (size_t)(tn_ * 128) * 128; \
        _Pragma("unroll") for (int s_ = 0; s_ < 2; ++s_) _Pragma("unroll") for (int i = 0; i < 4; ++i) { \
            ra[s_][i] = gload16_async(Ag + (size_t)(lrow + 32 * i) * 128 + s_ * 64 + lcc * 8); rb[s_][i] = gload16_async(Bg + (size_t)(lrow + 32 * i) * 128 + s_ * 64 + lcc * 8); } }
    int it = 0;
    int q = ((it * 8 + (B & 7)) * (G >> 3)) + (B >> 3);
    if (q < count) KVS_ISSUE(q);
    while (q < count) {
        tile_map(first + q, 8, tm, tn);
        wait_vm0();
#pragma unroll
        for (int s_ = 0; s_ < 2; ++s_)
#pragma unroll
            for (int i = 0; i < 4; ++i) {
                *(u32x4*)(smem + s_ * 36864 + (lrow + 32 * i) * 144 + lcc * 16) = ra[s_][i];
                *(u32x4*)(smem + s_ * 36864 + 18432 + (lrow + 32 * i) * 144 + lcc * 16) = rb[s_][i];
            }
        __syncthreads();
        ++it;
        const int qn = ((it * 8 + (B & 7)) * (G >> 3)) + (B >> 3);
        if (qn < count) KVS_ISSUE(qn);
        f32x16 acc[2][2];
#pragma unroll
        for (int a = 0; a < 2; ++a)
#pragma unroll
            for (int b = 0; b < 2; ++b)
#pragma unroll
                for (int i = 0; i < 16; ++i) acc[a][b][i] = 0.f;
#pragma unroll
        for (int kk = 0; kk < 8; ++kk) {
            const unsigned char* cur = smem + (kk >> 2) * 36864;
            const int ks = kk & 3;
            bf16x8 bf[2], af[2];
#pragma unroll
            for (int nt = 0; nt < 2; ++nt) bf[nt] = *(const bf16x8*)(cur + 18432 + (wn * 64 + 32 * nt + r) * 144 + (16 * ks + 8 * h) * 2);
#pragma unroll
            for (int mt = 0; mt < 2; ++mt) af[mt] = *(const bf16x8*)(cur + (wm * 64 + 32 * mt + r) * 144 + (16 * ks + 8 * h) * 2);
#pragma unroll
            for (int nt = 0; nt < 2; ++nt)
#pragma unroll
                for (int mt = 0; mt < 2; ++mt) acc[nt][mt] = MFMA32(bf[nt], af[mt], acc[nt][mt]);
        }
        __syncthreads();
        bf16_t* dst = (bf16_t*)(P.ws + (tn < 4 ? WS_KNP : WS_VP));
        const int dcol0 = (tn & 3) * 128;
#pragma unroll
        for (int mt = 0; mt < 2; ++mt) {
            float ri = 1.f;
            if (tn < 4) {
                float ss = 0.f;
#pragma unroll
                for (int nt = 0; nt < 2; ++nt)
#pragma unroll
                    for (int i = 0; i < 16; ++i) ss += acc[nt][mt][i] * acc[nt][mt][i];
                ss += __shfl_xor(ss, 32);
                ri = __builtin_amdgcn_rsqf(ss * (1.f / 64.f) + EPS);
            }
#pragma unroll
            for (int nt = 0; nt < 2; ++nt)
#pragma unroll
                for (int g = 0; g < 4; ++g) {
                    float4 gg = make_float4(1.f, 1.f, 1.f, 1.f);
                    if (tn < 4) gg = ggk[nt][g];
                    uint2 b; b.x = pack2(acc[nt][mt][4 * g] * ri * gg.x, acc[nt][mt][4 * g + 1] * ri * gg.y);
                    b.y = pack2(acc[nt][mt][4 * g + 2] * ri * gg.z, acc[nt][mt][4 * g + 3] * ri * gg.w);
                    *(uint2*)(smem + (wm * 64 + 32 * mt + r) * 272 + (wn * 64 + 32 * nt + 8 * g + 4 * h) * 2) = b;
                }
        }
        __syncthreads();
#pragma unroll
        for (int i2 = 0; i2 < 8; ++i2) {
            const int row = i2 * 16 + (tid >> 4), cc = tid & 15;
            const u32x4 v = *(const u32x4*)(smem + row * 272 + cc * 16);
            *(u32x4*)(dst + (size_t)(tm * 128 + row) * 512 + dcol0 + cc * 8) = v;
        }
        __syncthreads();
        q = qn;
    }
#undef KVS_ISSUE
}

DI void rowpass(const Params& P, const int l, const int j) {
    const int tid_ = otid(); const int lane = tid_ & 63, wave = tid_ >> 6;
    const int row = j * 4 + wave;
    const bf16_t* pr = (const bf16_t*)(P.ws + WS_PROJ) + (size_t)row * 2048;
    const uint2 u_cq = *(const uint2*)(pr + 1536 + lane * 4);
    const unsigned u_ckv = *(const unsigned*)(pr + 1792 + lane * 2);
    const bf16_t u_kr = pr[1920 + (lane & 31)];
    const float2 g_ckv = *(const float2*)(P.in[21] + l * 128 + lane * 2);
    const float g_kr = P.in[20][l * 32 + (lane & 31)];
    {
        float a = lo16(u_cq.x), b = hi16(u_cq.x), c = lo16(u_cq.y), d = hi16(u_cq.y);
        float ss = wave_sum(a * a + b * b + c * c + d * d);
        const float ri = __builtin_amdgcn_rsqf(ss * (1.f / 256.f) + EPS);
        uint2 o; o.x = pack2(a * ri, b * ri); o.y = pack2(c * ri, d * ri);
        *(uint2*)((bf16_t*)(P.ws + WS_CQN) + (size_t)row * 256 + lane * 4) = o;
    }
    {
        float a = lo16(u_ckv), b = hi16(u_ckv);
        float ss = wave_sum(a * a + b * b);
        const float ri = __builtin_amdgcn_rsqf(ss * (1.f / 128.f) + EPS);
        a = a * ri * g_ckv.x; b = b * ri * g_ckv.y;
        float* fo = row < R_P ? P.out + O_LAT_P + ((size_t)l * R_P + row) * 128 : P.out + O_LAT_S + ((size_t)l * R_S + (row - R_P)) * 128;
        *(float2*)(fo + lane * 2) = make_float2(a, b);
        *(unsigned*)((bf16_t*)(P.ws + WS_LATB) + (size_t)row * 128 + lane * 2) = pack2(a, b);
    }
    {
        float v = lane < 32 ? bf2f(u_kr) : 0.f;
        float ss = wave_sum(v * v);
        const float ri = __builtin_amdgcn_rsqf(ss * (1.f / 32.f) + EPS);
        float y = v * ri * g_kr;
        float other = __shfl_xor(y, 16);
        float c, s; rope_cs(row_pos(row), lane & 15, c, s);
        float o = (lane & 16) ? (other * s + y * c) : (y * c - other * s);
        if (lane < 32) {
            float* fo = row < R_P ? P.out + O_KR_P + ((size_t)l * R_P + row) * 32 : P.out + O_KR_S + ((size_t)l * R_S + (row - R_P)) * 32;
            fo[lane] = o;
            ((bf16_t*)(P.ws + WS_KRB))[(size_t)row * 32 + lane] = (bf16_t)(pack2(o, 0.f) & 0xffff);
        }
    }
}

DI void gla_job_rows(int j, int& row0, int& h) {
    if (j < 1024) { row0 = (j >> 8) * 4096 + (j & 63) * 64; h = (j >> 6) & 3; }
    else { const int s = j - 1024; row0 = R_P + (s >> 2) * 64; h = s & 3; }
}
DI void gla_stepA(const Params& P, const int l, const int j, unsigned char* smem) {
    float* lb = (float*)smem;
    float* kk = lb + 64 * 33;
    float* vv = kk + 64 * 33;
    float* agl = vv + 64 * 64;
    const int tid = otid();
    int row0, h; gla_job_rows(j, row0, h);
    const bf16_t* pb = (const bf16_t*)(P.ws + WS_PROJ);
    if (tid < 128) {
        const int t = tid >> 1, half = tid & 1;
        const uint4 ua = *(const uint4*)(pb + (size_t)(row0 + t) * 2048 + 1952 + half * 8);
        float* ap = agl + t * 16 + half * 8;
        *(float4*)ap = make_float4(lo16(ua.x), hi16(ua.x), lo16(ua.y), hi16(ua.y));
        *(float4*)(ap + 4) = make_float4(lo16(ua.z), hi16(ua.z), lo16(ua.w), hi16(ua.w));
    }
    __syncthreads();
    {
        const int t = tid >> 2, kq = (tid & 3) * 8;
        const float* Wg = P.in[12] + (size_t)l * 16 * 128 + h * 32 + kq;
        const float* bg = P.in[13] + l * 128 + h * 32 + kq;
        float z[8];
#pragma unroll
        for (int q = 0; q < 8; ++q) z[q] = bg[q];
#pragma unroll
        for (int rr = 0; rr < 16; ++rr) {
            const float a = agl[t * 16 + rr];
#pragma unroll
            for (int q = 0; q < 8; ++q) z[q] += a * Wg[rr * 128 + q];
        }
#pragma unroll
        for (int q = 0; q < 8; ++q) {
            const float zz = z[q];
            const float ls = fminf(zz, 0.f) - LN2 * __builtin_amdgcn_logf(1.f + __builtin_amdgcn_exp2f(-fabsf(zz) * LOG2E));
            lb[t * 33 + kq + q] = ls * (1.f / 16.f);
        }
    }
    __syncthreads();
    {
        const int k = tid & 31, seg = tid >> 5;
        float loc[8]; float run = 0.f;
#pragma unroll
        for (int i = 0; i < 8; ++i) { run += lb[(seg * 8 + i) * 33 + k]; loc[i] = run; }
        agl[seg * 32 + k] = run;
        __syncthreads();
        float off = 0.f;
#pragma unroll
        for (int s2 = 0; s2 < 8; ++s2) off += (s2 < seg) ? agl[s2 * 32 + k] : 0.f;
#pragma unroll
        for (int i = 0; i < 8; ++i) lb[(seg * 8 + i) * 33 + k] = loc[i] + off;
    }
    __syncthreads();
    float* glab = (float*)(P.ws + WS_GLAB) + (size_t)(l * 0 + j) * 2048;
    for (int e = tid; e < 2048; e += 256) { const int t = e >> 5, k = e & 31; glab[e] = lb[t * 33 + k]; }
    if (tid < 32) ((float*)(P.ws + WS_GDEC))[(size_t)j * 32 + tid] = __builtin_amdgcn_exp2f(lb[63 * 33 + tid] * LOG2E);
    {
        const int token = tid >> 2, part = tid & 3;
        const uint4 uk = *(const uint4*)(pb + (size_t)(row0 + token) * 2048 + 896 + h * 32 + part * 8);
        const int c0 = tid, c1 = tid + 256;
        const uint4 uv0 = *(const uint4*)(pb + (size_t)(row0 + (c0 >> 3)) * 2048 + 1024 + h * 64 + (c0 & 7) * 8);
        const uint4 uv1 = *(const uint4*)(pb + (size_t)(row0 + (c1 >> 3)) * 2048 + 1024 + h * 64 + (c1 & 7) * 8);
        const float kv[8] = {lo16(uk.x), hi16(uk.x), lo16(uk.y), hi16(uk.y), lo16(uk.z), hi16(uk.z), lo16(uk.w), hi16(uk.w)};
#pragma unroll
        for (int i = 0; i < 8; ++i) {
            const int k = part * 8 + i;
            kk[token * 33 + k] = kv[i] * __builtin_amdgcn_exp2f((lb[63 * 33 + k] - lb[token * 33 + k]) * LOG2E);
        }
        float* v0p = vv + (c0 >> 3) * 64 + (c0 & 7) * 8;
        *(float4*)v0p = make_float4(lo16(uv0.x), hi16(uv0.x), lo16(uv0.y), hi16(uv0.y));
        *(float4*)(v0p + 4) = make_float4(lo16(uv0.z), hi16(uv0.z), lo16(uv0.w), hi16(uv0.w));
        float* v1p = vv + (c1 >> 3) * 64 + (c1 & 7) * 8;
        *(float4*)v1p = make_float4(lo16(uv1.x), hi16(uv1.x), lo16(uv1.y), hi16(uv1.y));
        *(float4*)(v1p + 4) = make_float4(lo16(uv1.z), hi16(uv1.z), lo16(uv1.w), hi16(uv1.w));
    }
    __syncthreads();
    {
        const int k = tid >> 3, v8 = (tid & 7) * 8;
        float a[8];
#pragma unroll
        for (int q = 0; q < 8; ++q) a[q] = 0.f;
        for (int t = 0; t < 64; ++t) {
            const float kv = kk[t * 33 + k];
#pragma unroll
            for (int q = 0; q < 8; ++q) a[q] += kv * vv[t * 64 + v8 + q];
        }
        float* loc = (float*)(P.ws + WS_GLOC) + (size_t)j * 2048 + k * 64 + v8;
        *(float4*)loc = make_float4(a[0], a[1], a[2], a[3]);
        *(float4*)(loc + 4) = make_float4(a[4], a[5], a[6], a[7]);
    }
    __syncthreads();
}
DI void gla_stepB(const Params& P, const int l, const int sq) {
    const int tid = otid();
    const int e0 = tid * 8, k = e0 >> 6;
    float S[8];
    int j0, nch; float* so;
    if (sq < 16) {
        j0 = sq * 64; nch = 64;
#pragma unroll
        for (int q = 0; q < 8; ++q) S[q] = 0.f;
        so = P.out + O_GLA_P + ((size_t)l * 16 + sq) * 2048;
    } else {
        const int s = sq - 16; j0 = 1024 + s; nch = 1;
        const float* s0 = P.in[5] + ((size_t)l * 128 + s) * 2048 + e0;
        float4 a = *(const float4*)s0, b = *(const float4*)(s0 + 4);
        S[0] = a.x; S[1] = a.y; S[2] = a.z; S[3] = a.w; S[4] = b.x; S[5] = b.y; S[6] = b.z; S[7] = b.w;
        so = P.out + O_GLA_S + ((size_t)l * 128 + s) * 2048;
    }
    const float* __restrict__ loc = (const float*)(P.ws + WS_GLOC);
    const float* __restrict__ dec = (const float*)(P.ws + WS_GDEC);
    float* __restrict__ st = (float*)(P.ws + WS_GST);
    for (int c0 = 0; c0 < nch; c0 += 8) {
        float4 A[8], Bv[8]; float Dd[8];
#pragma unroll
        for (int u = 0; u < 8; ++u) {
            const size_t jj = (size_t)(j0 + (c0 + u < nch ? c0 + u : nch - 1));
            Dd[u] = dec[jj * 32 + k];
            A[u] = *(const float4*)(loc + jj * 2048 + e0);
            Bv[u] = *(const float4*)(loc + jj * 2048 + e0 + 4);
        }
#pragma unroll
        for (int u = 0; u < 8; ++u) {
            if (c0 + u < nch) {
                float* sp = st + (size_t)(j0 + c0 + u) * 2048 + e0;
                *(float4*)sp = make_float4(S[0], S[1], S[2], S[3]);
                *(float4*)(sp + 4) = make_float4(S[4], S[5], S[6], S[7]);
                const float d = Dd[u];
                S[0] = d * S[0] + A[u].x; S[1] = d * S[1] + A[u].y; S[2] = d * S[2] + A[u].z; S[3] = d * S[3] + A[u].w;
                S[4] = d * S[4] + Bv[u].x; S[5] = d * S[5] + Bv[u].y; S[6] = d * S[6] + Bv[u].z; S[7] = d * S[7] + Bv[u].w;
            }
        }
    }
    *(float4*)(so + e0) = make_float4(S[0], S[1], S[2], S[3]);
    *(float4*)(so + e0 + 4) = make_float4(S[4], S[5], S[6], S[7]);
}
DI void gla_stepC(const Params& P, const int l, const int j, unsigned char* smem) {
    float* qs = (float*)smem;
    float* ks = qs + 64 * 33;
    float* att = ks + 64 * 33;
    float* vs = att + 64 * 65;
    float* Ss = vs + 64 * 64;
    const int tid = otid();
    int row0, h; gla_job_rows(j, row0, h);
    const bf16_t* pb = (const bf16_t*)(P.ws + WS_PROJ);
    const float* glab = (const float*)(P.ws + WS_GLAB) + (size_t)j * 2048;
    const float scale = 0.17677669529663687f;
    {
        const int token = tid >> 2, part = tid & 3;
        const bf16_t* prow = pb + (size_t)(row0 + token) * 2048;
        const uint4 uq = *(const uint4*)(prow + 768 + h * 32 + part * 8);
        const uint4 uk = *(const uint4*)(prow + 896 + h * 32 + part * 8);
        const float4 b0 = *(const float4*)(glab + token * 32 + part * 8), b1 = *(const float4*)(glab + token * 32 + part * 8 + 4);
        const int c0 = tid, c1 = tid + 256;
        const uint4 uv0 = *(const uint4*)(pb + (size_t)(row0 + (c0 >> 3)) * 2048 + 1024 + h * 64 + (c0 & 7) * 8);
        const uint4 uv1 = *(const uint4*)(pb + (size_t)(row0 + (c1 >> 3)) * 2048 + 1024 + h * 64 + (c1 & 7) * 8);
        const float* st = (const float*)(P.ws + WS_GST) + (size_t)j * 2048;
        const float4 s0 = *(const float4*)(st + tid * 4), s1 = *(const float4*)(st + 1024 + tid * 4);
        const float qv[8] = {lo16(uq.x), hi16(uq.x), lo16(uq.y), hi16(uq.y), lo16(uq.z), hi16(uq.z), lo16(uq.w), hi16(uq.w)};
        const float kv[8] = {lo16(uk.x), hi16(uk.x), lo16(uk.y), hi16(uk.y), lo16(uk.z), hi16(uk.z), lo16(uk.w), hi16(uk.w)};
        const float bv[8] = {b0.x, b0.y, b0.z, b0.w, b1.x, b1.y, b1.z, b1.w};
#pragma unroll
        for (int i = 0; i < 8; ++i) {
            qs[token * 33 + part * 8 + i] = qv[i] * __builtin_amdgcn_exp2f(bv[i] * LOG2E) * scale;
            ks[token * 33 + part * 8 + i] = kv[i] * __builtin_amdgcn_exp2f(-bv[i] * LOG2E);
        }
        float* v0p = vs + (c0 >> 3) * 64 + (c0 & 7) * 8;
        *(float4*)v0p = make_float4(lo16(uv0.x), hi16(uv0.x), lo16(uv0.y), hi16(uv0.y));
        *(float4*)(v0p + 4) = make_float4(lo16(uv0.z), hi16(uv0.z), lo16(uv0.w), hi16(uv0.w));
        float* v1p = vs + (c1 >> 3) * 64 + (c1 & 7) * 8;
        *(float4*)v1p = make_float4(lo16(uv1.x), hi16(uv1.x), lo16(uv1.y), hi16(uv1.y));
        *(float4*)(v1p + 4) = make_float4(lo16(uv1.z), hi16(uv1.z), lo16(uv1.w), hi16(uv1.w));
        *(float4*)(Ss + tid * 4) = s0;
        *(float4*)(Ss + 1024 + tid * 4) = s1;
    }
    __syncthreads();
    const int ty = tid >> 4, tx = tid & 15;
    {
        float a[4][4];
#pragma unroll
        for (int i = 0; i < 4; ++i)
#pragma unroll
            for (int q = 0; q < 4; ++q) a[i][q] = 0.f;
#pragma unroll 4
        for (int k = 0; k < 32; ++k) {
            float qv[4], kv[4];
#pragma unroll
            for (int i = 0; i < 4; ++i) { qv[i] = qs[(4 * ty + i) * 33 + k]; kv[i] = ks[(4 * tx + i) * 33 + k]; }
#pragma unroll
            for (int i = 0; i < 4; ++i)
#pragma unroll
                for (int q = 0; q < 4; ++q) a[i][q] += qv[i] * kv[q];
        }
#pragma unroll
        for (int i = 0; i < 4; ++i)
#pragma unroll
            for (int q = 0; q < 4; ++q) { const int t = 4 * ty + i, s = 4 * tx + q; att[t * 65 + s] = (s <= t) ? a[i][q] : 0.f; }
    }
    __syncthreads();
    {
        float o[4][4];
#pragma unroll
        for (int i = 0; i < 4; ++i)
#pragma unroll
            for (int q = 0; q < 4; ++q) o[i][q] = 0.f;
#pragma unroll 4
        for (int k = 0; k < 32; ++k) {
            float qv[4];
#pragma unroll
            for (int i = 0; i < 4; ++i) qv[i] = qs[(4 * ty + i) * 33 + k];
            const float4 sv = *(const float4*)(Ss + k * 64 + 4 * tx);
#pragma unroll
            for (int i = 0; i < 4; ++i) { o[i][0] += qv[i] * sv.x; o[i][1] += qv[i] * sv.y; o[i][2] += qv[i] * sv.z; o[i][3] += qv[i] * sv.w; }
        }
#pragma unroll 4
        for (int s = 0; s < 64; ++s) {
            float av[4];
#pragma unroll
            for (int i = 0; i < 4; ++i) av[i] = att[(4 * ty + i) * 65 + s];
            const float4 sv = *(const float4*)(vs + s * 64 + 4 * tx);
#pragma unroll
            for (int i = 0; i < 4; ++i) { o[i][0] += av[i] * sv.x; o[i][1] += av[i] * sv.y; o[i][2] += av[i] * sv.z; o[i][3] += av[i] * sv.w; }
        }
        const float4 gg = *(const float4*)(P.in[14] + l * 64 + 4 * tx);
        bf16_t* mix = (bf16_t*)(P.ws + WS_MIX);
        uint2 rgu[4];
#pragma unroll
        for (int i = 0; i < 4; ++i) rgu[i] = *(const uint2*)(pb + (size_t)(row0 + 4 * ty + i) * 2048 + 1280 + h * 64 + 4 * tx);
#pragma unroll
        for (int i = 0; i < 4; ++i) {
            float ss = o[i][0] * o[i][0] + o[i][1] * o[i][1] + o[i][2] * o[i][2] + o[i][3] * o[i][3];
            ss += __shfl_xor(ss, 1); ss += __shfl_xor(ss, 2); ss += __shfl_xor(ss, 4); ss += __shfl_xor(ss, 8);
            const float ri = __builtin_amdgcn_rsqf(ss * (1.f / 64.f) + EPS);
            const size_t row = (size_t)(row0 + 4 * ty + i);
            const uint2 ru = rgu[i];
            const float r0 = lo16(ru.x), r1 = hi16(ru.x), r2 = lo16(ru.y), r3 = hi16(ru.y);
            uint2 b; b.x = pack2(o[i][0] * ri * gg.x * silu(r0), o[i][1] * ri * gg.y * silu(r1));
            b.y = pack2(o[i][2] * ri * gg.z * silu(r2), o[i][3] * ri * gg.w * silu(r3));
            *(uint2*)(mix + row * 1024 + 256 + h * 64 + 4 * tx) = b;
        }
    }
    __syncthreads();
}

struct AttnJob {
    const bf16_t* q0; int q0s; const bf16_t* q1; int q1s;
    int NT, npast, diag;
    const bf16_t* kn0; int kn0s; const bf16_t* kn1; int kn1s; const bf16_t* vn; int vns;
    const bf16_t* kp0; int kp0s; const bf16_t* kp1; int kp1s; const bf16_t* vp; int vps;
    const float* knf; const float* vnf; const float* kpf; const float* vpf; int pfs;
    bf16_t* out; int outs; const float* gain;
};

template <int HD0, int HD1, int DV, bool F32OK, int NTH, int NKR, int NVR>
DI void attn_issue_tile(const AttnJob& J, const int kt, u32x4 (&tk)[NKR], u32x4 (&tv)[NVR], const int p) {
    constexpr int CK = (HD0 + HD1) / 8, CV = DV / 8, NK = 64 * CK / NTH, NV = 64 * CV / NTH;
    const bool past = kt < J.npast;
    const int key0 = past ? kt * 64 : (kt - J.npast) * 64;
    if constexpr (F32OK) {
        const float* kb = past ? J.kpf : J.knf;
        const float* vb = past ? J.vpf : J.vnf;
#pragma unroll
        for (int i = 0; i < NK; ++i) {
            const int c = p + NTH * i, key = c / CK, part = c % CK;
            const float* s = kb + (size_t)(key0 + key) * J.pfs + part * 8;
            tk[2 * i] = gload16_async_nt(s); tk[2 * i + 1] = gload16_async_nt(s + 4);
        }
#pragma unroll
        for (int i = 0; i < NV; ++i) {
            const int c = p + NTH * i, key = c / CV, part = c % CV;
            const float* s = vb + (size_t)(key0 + key) * J.pfs + part * 8;
            tv[2 * i] = gload16_async_nt(s); tv[2 * i + 1] = gload16_async_nt(s + 4);
        }
    } else {
        const bf16_t* k0 = past ? J.kp0 : J.kn0; const int k0s = past ? J.kp0s : J.kn0s;
        const bf16_t* k1 = past ? J.kp1 : J.kn1; const int k1s = past ? J.kp1s : J.kn1s;
        const bf16_t* vsrc = past ? J.vp : J.vn; const int vss = past ? J.vps : J.vns;
#pragma unroll
        for (int i = 0; i < NK; ++i) {
            const int c = p + NTH * i, key = c / CK, part = c % CK;
            const bf16_t* s;
            if (HD1 == 0 || part < HD0 / 8) s = k0 + (size_t)(key0 + key) * k0s + part * 8;
            else s = k1 + (size_t)(key0 + key) * k1s + (part - HD0 / 8) * 8;
            tk[i] = gload16_async(s);
        }
#pragma unroll
        for (int i = 0; i < NV; ++i) {
            const int c = p + NTH * i, key = c / CV, part = c % CV;
            tv[i] = gload16_async(vsrc + (size_t)(key0 + key) * vss + part * 8);
        }
    }
}
DI u32x4 cvt8r(const u32x4 a, const u32x4 b) {
    u32x4 r;
    r.x = pack2(__uint_as_float(a.x), __uint_as_float(a.y)); r.y = pack2(__uint_as_float(a.z), __uint_as_float(a.w));
    r.z = pack2(__uint_as_float(b.x), __uint_as_float(b.y)); r.w = pack2(__uint_as_float(b.z), __uint_as_float(b.w));
    return r;
}
DI void vt_scatter(bf16_t* vt, const u32x4 u) {
    vt[0] = u.x & 0xffff; vt[68] = u.x >> 16; vt[136] = u.y & 0xffff; vt[204] = u.y >> 16;
    vt[272] = u.z & 0xffff; vt[340] = u.z >> 16; vt[408] = u.w & 0xffff; vt[476] = u.w >> 16;
}
template <int HD0, int HD1, int DV, bool F32OK, int NTH, int NKR, int NVR>
DI void attn_store_tile(const AttnJob& J, const int kt, const u32x4 (&tk)[NKR], const u32x4 (&tv)[NVR], unsigned char* Ks, unsigned char* Vt, const int p) {
    constexpr int HD = HD0 + HD1, CK = HD / 8, CV = DV / 8, KSTR = (HD + 8) * 2, NK = 64 * CK / NTH, NV = 64 * CV / NTH;
#pragma unroll
    for (int i = 0; i < NK; ++i) {
        const int c = p + NTH * i, key = c / CK, part = c % CK;
        u32x4 u;
        if constexpr (F32OK) u = cvt8r(tk[2 * i], tk[2 * i + 1]); else u = tk[i];
        *(u32x4*)(Ks + key * KSTR + part * 16) = u;
    }
#pragma unroll
    for (int i = 0; i < NV; ++i) {
        const int c = p + NTH * i, key = c / CV, part = c % CV;
        u32x4 u;
        if constexpr (F32OK) u = cvt8r(tv[2 * i], tv[2 * i + 1]); else u = tv[i];
        *(u32x4*)(Vt + key * (DV * 2 + 16) + part * 16) = u;
    }
}

template <int MODE, int HD0, int HD1, int DV, bool F32OK, bool PF>
DI void attn_job(const AttnJob& J, unsigned char* smem) {
    constexpr int HD = HD0 + HD1, NKS = HD / 16, NDT = DV / 32, KSTR = (HD + 8) * 2;
    constexpr int VSTR = DV * 2 + 16;
    constexpr int KBYTES = 64 * KSTR, VBYTES = 64 * VSTR, PAIRB = KBYTES + VBYTES;
    const int tid = otid(), lane = tid & 63, wave = tid >> 6, r = lane & 31, h = lane >> 5;
    const int qh = wave & 1, kh = wave >> 1, p = tid & 127;
    unsigned char* Ks = smem + kh * PAIRB;
    unsigned char* Vt = Ks + KBYTES;
    const int NT = J.NT, n0 = (NT + 1) >> 1, n1 = NT - n0;
    constexpr int NKR = (64 * (HD / 8) / 128) * (F32OK ? 2 : 1), NVR = (64 * (DV / 8) / 128) * (F32OK ? 2 : 1);
    u32x4 tk[NKR], tv[NVR];
    {
        const int kt0 = kh == 0 ? NT - 1 : n1 - 1;
        if (PF && kt0 >= 0) attn_issue_tile<HD0, HD1, DV, F32OK, 128>(J, kt0, tk, tv, p);
    }
    bf16x8 qf[NKS];
#pragma unroll
    for (int ks = 0; ks < NKS; ++ks) {
        if (16 * ks < HD0) qf[ks] = *(const bf16x8*)(J.q0 + (size_t)(32 * qh + r) * J.q0s + 16 * ks + 8 * h);
        else qf[ks] = *(const bf16x8*)(J.q1 + (size_t)(32 * qh + r) * J.q1s + (16 * ks - HD0) + 8 * h);
    }
    f32x16 oT[NDT];
#pragma unroll
    for (int dt = 0; dt < NDT; ++dt)
#pragma unroll
        for (int i = 0; i < 16; ++i) oT[dt][i] = 0.f;
    float m_run = -1e30f, l_run = 0.f, R = (MODE == 1) ? 1.f : 0.f;
    for (int it = 0; it < n0; ++it) {
        const int kt = kh == 0 ? NT - 1 - it : n1 - 1 - it;
        const bool active = kt >= 0;
        if (!PF && active) attn_issue_tile<HD0, HD1, DV, F32OK, 128>(J, kt, tk, tv, p);
        wait_vm0();
        __syncthreads();
        if (active) attn_store_tile<HD0, HD1, DV, F32OK, 128>(J, kt, tk, tv, Ks, Vt, p);
        __syncthreads();
        if (PF && it + 1 < n0 && kt - 1 >= 0) attn_issue_tile<HD0, HD1, DV, F32OK, 128>(J, kt - 1, tk, tv, p);
        if (!active) continue;
        f32x16 sT[2];
#pragma unroll
        for (int mt = 0; mt < 2; ++mt) {
#pragma unroll
            for (int i = 0; i < 16; ++i) sT[mt][i] = 0.f;
#pragma unroll
            for (int ks = 0; ks < NKS; ++ks) {
                const bf16x8 a = *(const bf16x8*)(Ks + (32 * mt + r) * KSTR + (16 * ks + 8 * h) * 2);
                sT[mt] = MFMA32(a, qf[ks], sT[mt]);
            }
        }
        if (MODE == 0) {
            float mx = sT[0][0];
#pragma unroll
            for (int mt = 0; mt < 2; ++mt)
#pragma unroll
                for (int i = 0; i < 16; ++i) mx = fmaxf(mx, sT[mt][i]);
            mx = fmaxf(mx, __shfl_xor(mx, 32));
            const float m_new = fmaxf(m_run, mx);
            const float alpha = __builtin_amdgcn_exp2f(m_run - m_new);
            m_run = m_new;
            float ps = 0.f;
#pragma unroll
            for (int mt = 0; mt < 2; ++mt)
#pragma unroll
                for (int i = 0; i < 16; ++i) { const float pv = __builtin_amdgcn_exp2f(sT[mt][i] - m_new); sT[mt][i] = pv; ps += pv; }
            l_run = l_run * alpha + ps;
#pragma unroll
            for (int dt = 0; dt < NDT; ++dt)
#pragma unroll
                for (int i = 0; i < 16; ++i) oT[dt][i] *= alpha;
        } else {
            const bool dg = J.diag && (kt == NT - 1);
            const int qi = 32 * qh + r;
            float kp[2][16];
#pragma unroll
            for (int mt = 0; mt < 2; ++mt)
#pragma unroll
                for (int i = 0; i < 16; ++i) {
                    const float t = fminf(sT[mt][i] * (-0.125f * LOG2E), 115.f);
                    const float e = __builtin_amdgcn_exp2f(t);
                    const float sg = __builtin_amdgcn_rcpf(1.f + e);
                    const bool masked = dg && (32 * mt + crow(i, h) >= qi);
                    sT[mt][i] = masked ? 0.f : sg;
                    kp[mt][i] = masked ? 1.f : e * sg;
                }
            float G[2][4], Go[2][4];
#pragma unroll
            for (int mt = 0; mt < 2; ++mt)
#pragma unroll
                for (int g = 0; g < 4; ++g) {
                    G[mt][g] = (kp[mt][4 * g] * kp[mt][4 * g + 1]) * (kp[mt][4 * g + 2] * kp[mt][4 * g + 3]);
                    Go[mt][g] = __shfl_xor(G[mt][g], 32);
                }
            float run = R;
#pragma unroll
            for (int mt = 1; mt >= 0; --mt)
#pragma unroll
                for (int g = 3; g >= 0; --g) {
                    const float after = h ? run : run * Go[mt][g];
                    const float p3 = after, p2 = p3 * kp[mt][4 * g + 3], p1 = p2 * kp[mt][4 * g + 2], p0 = p1 * kp[mt][4 * g + 1];
                    sT[mt][4 * g + 3] *= p3;
                    sT[mt][4 * g + 2] *= p2;
                    sT[mt][4 * g + 1] *= p1;
                    sT[mt][4 * g + 0] *= p0;
                    run *= G[mt][g] * Go[mt][g];
                }
            R = run;
        }
#pragma unroll
        for (int mt = 0; mt < 2; ++mt)
#pragma unroll
            for (int s = 0; s < 2; ++s) {
                uint4 pu;
                pu.x = pack2(sT[mt][8 * s], sT[mt][8 * s + 1]); pu.y = pack2(sT[mt][8 * s + 2], sT[mt][8 * s + 3]);
                pu.z = pack2(sT[mt][8 * s + 4], sT[mt][8 * s + 5]); pu.w = pack2(sT[mt][8 * s + 6], sT[mt][8 * s + 7]);
                const bf16x8 pf = __builtin_bit_cast(bf16x8, pu);
#pragma unroll
                for (int dt = 0; dt < NDT; ++dt) {
                    const unsigned char* vp = Vt + (32 * mt + 16 * s + 4 * h + ((lane & 15) >> 2)) * VSTR + dt * 64 + ((lane >> 4) & 1) * 32 + (lane & 3) * 8;
                    const s16x4 a0 = __builtin_amdgcn_ds_read_tr16_b64_v4i16((LAS s16x4*)vp);
                    const s16x4 a1 = __builtin_amdgcn_ds_read_tr16_b64_v4i16((LAS s16x4*)(vp + 8 * VSTR));
                    const bf16x8 av = __builtin_shufflevector(a0, a1, 0, 1, 2, 3, 4, 5, 6, 7);
                    oT[dt] = MFMA32(av, pf, oT[dt]);
                }
            }
    }
    __syncthreads();
    float* X = (float*)smem + (size_t)qh * (NDT * 16 + 2) * 64;
    if (kh == 1) {
#pragma unroll
        for (int dt = 0; dt < NDT; ++dt)
#pragma unroll
            for (int i = 0; i < 16; ++i) X[(dt * 16 + i) * 64 + lane] = oT[dt][i];
        X[(NDT * 16) * 64 + lane] = MODE == 0 ? m_run : R;
        X[(NDT * 16 + 1) * 64 + lane] = l_run;
    }
    __syncthreads();
    if (kh == 0) {
        if (MODE == 0) {
            const float m1 = X[(NDT * 16) * 64 + lane], l1 = X[(NDT * 16 + 1) * 64 + lane];
            const float m = fmaxf(m_run, m1);
            const float a0 = __builtin_amdgcn_exp2f(m_run - m), a1 = __builtin_amdgcn_exp2f(m1 - m);
            float lt = l_run * a0 + l1 * a1;
            lt += __shfl_xor(lt, 32);
            const float inv = __builtin_amdgcn_rcpf(lt);
#pragma unroll
            for (int dt = 0; dt < NDT; ++dt)
#pragma unroll
                for (int i = 0; i < 16; ++i) oT[dt][i] = (oT[dt][i] * a0 + X[(dt * 16 + i) * 64 + lane] * a1) * inv;
        } else {
            const float f = R;
#pragma unroll
            for (int dt = 0; dt < NDT; ++dt)
#pragma unroll
                for (int i = 0; i < 16; ++i) oT[dt][i] += f * X[(dt * 16 + i) * 64 + lane];
        }
        float ri = 1.f;
        if (J.gain) {
            float ss = 0.f;
#pragma unroll
            for (int dt = 0; dt < NDT; ++dt)
#pragma unroll
                for (int i = 0; i < 16; ++i) ss += oT[dt][i] * oT[dt][i];
            ss += __shfl_xor(ss, 32);
            ri = __builtin_amdgcn_rsqf(ss * (1.f / DV) + EPS);
        }
        bf16_t* orow = J.out + (size_t)(32 * qh + r) * J.outs;
        float4 ggv[NDT][4];
#pragma unroll
        for (int dt = 0; dt < NDT; ++dt)
#pragma unroll
            for (int g = 0; g < 4; ++g) ggv[dt][g] = J.gain ? *(const float4*)(J.gain + 32 * dt + 8 * g + 4 * h) : make_float4(1.f, 1.f, 1.f, 1.f);
#pragma unroll
        for (int dt = 0; dt < NDT; ++dt)
#pragma unroll
            for (int g = 0; g < 4; ++g) {
                const int d = 32 * dt + 8 * g + 4 * h;
                const float4 gg = ggv[dt][g];
                uint2 b; b.x = pack2(oT[dt][4 * g] * ri * gg.x, oT[dt][4 * g + 1] * ri * gg.y); b.y = pack2(oT[dt][4 * g + 2] * ri * gg.z, oT[dt][4 * g + 3] * ri * gg.w);
                *(uint2*)(orow + d) = b;
            }
    }
    __syncthreads();
}

template <int MODE, int HD0, int HD1, int DV>
DI void attn_job128(const AttnJob& J, const int qt2, unsigned char* smem) {
    constexpr int HD = HD0 + HD1, NKS = HD / 16, NDT = DV / 32, KSTR = (HD + 8) * 2, VSTR = DV * 2 + 16;
    constexpr int KBYTES = 64 * KSTR, VBYTES = 64 * VSTR, BUFB = KBYTES + VBYTES;
    const int tid = otid(), lane = tid & 63, wave = tid >> 6, r = lane & 31, h = lane >> 5;
    const int my_last = 2 * qt2 + (wave >> 1);
    const int NT = 2 * qt2 + 2;
    constexpr int NKR = 64 * (HD / 8) / 256, NVR = 64 * (DV / 8) / 256;
    u32x4 tk[NKR], tv[NVR];
    attn_issue_tile<HD0, HD1, DV, false, 256>(J, NT - 1, tk, tv, tid);
    bf16x8 qf[NKS];
#pragma unroll
    for (int ks = 0; ks < NKS; ++ks) {
        if (16 * ks < HD0) qf[ks] = *(const bf16x8*)(J.q0 + (size_t)(32 * wave + r) * J.q0s + 16 * ks + 8 * h);
        else qf[ks] = *(const bf16x8*)(J.q1 + (size_t)(32 * wave + r) * J.q1s + (16 * ks - HD0) + 8 * h);
    }
    f32x16 oT[NDT];
#pragma unroll
    for (int dt = 0; dt < NDT; ++dt)
#pragma unroll
        for (int i = 0; i < 16; ++i) oT[dt][i] = 0.f;
    float m_run = -1e30f, l_run = 0.f, R = (MODE == 1) ? 1.f : 0.f;
    for (int it = 0; it < NT; ++it) {
        const int kt = NT - 1 - it;
        unsigned char* Ks = smem + (it & 1) * BUFB;
        unsigned char* Vt = Ks + KBYTES;
        wait_vm0();
        attn_store_tile<HD0, HD1, DV, false, 256>(J, kt, tk, tv, Ks, Vt, tid);
        __syncthreads();
        if (it + 1 < NT) attn_issue_tile<HD0, HD1, DV, false, 256>(J, kt - 1, tk, tv, tid);
        if (kt > my_last) continue;
        f32x16 sT[2];
#pragma unroll
        for (int mt = 0; mt < 2; ++mt) {
#pragma unroll
            for (int i = 0; i < 16; ++i) sT[mt][i] = 0.f;
#pragma unroll
            for (int ks = 0; ks < NKS; ++ks) {
                const bf16x8 a = *(const bf16x8*)(Ks + (32 * mt + r) * KSTR + (16 * ks + 8 * h) * 2);
                sT[mt] = MFMA32(a, qf[ks], sT[mt]);
            }
        }
        if (MODE == 0) {
            float mx = sT[0][0];
#pragma unroll
            for (int mt = 0; mt < 2; ++mt)
#pragma unroll
                for (int i = 0; i < 16; ++i) mx = fmaxf(mx, sT[mt][i]);
            mx = fmaxf(mx, __shfl_xor(mx, 32));
            const float m_new = fmaxf(m_run, mx);
            const float alpha = __builtin_amdgcn_exp2f(m_run - m_new);
            m_run = m_new;
            float ps = 0.f;
#pragma unroll
            for (int mt = 0; mt < 2; ++mt)
#pragma unroll
                for (int i = 0; i < 16; ++i) { const float pv = __builtin_amdgcn_exp2f(sT[mt][i] - m_new); sT[mt][i] = pv; ps += pv; }
            l_run = l_run * alpha + ps;
#pragma unroll
            for (int dt = 0; dt < NDT; ++dt)
#pragma unroll
                for (int i = 0; i < 16; ++i) oT[dt][i] *= alpha;
        } else {
            const bool dg = (kt == my_last);
            const int qi = 32 * (wave & 1) + r;
            float kp[2][16];
#pragma unroll
            for (int mt = 0; mt < 2; ++mt)
#pragma unroll
                for (int i = 0; i < 16; ++i) {
                    const float t = fminf(sT[mt][i] * (-0.125f * LOG2E), 115.f);
                    const float e = __builtin_amdgcn_exp2f(t);
                    const float sg = __builtin_amdgcn_rcpf(1.f + e);
                    const bool masked = dg && (32 * mt + crow(i, h) >= qi);
                    sT[mt][i] = masked ? 0.f : sg;
                    kp[mt][i] = masked ? 1.f : e * sg;
                }
            float G[2][4], Go[2][4];
#pragma unroll
            for (int mt = 0; mt < 2; ++mt)
#pragma unroll
                for (int g = 0; g < 4; ++g) {
                    G[mt][g] = (kp[mt][4 * g] * kp[mt][4 * g + 1]) * (kp[mt][4 * g + 2] * kp[mt][4 * g + 3]);
                    Go[mt][g] = __shfl_xor(G[mt][g], 32);
                }
            float run = R;
#pragma unroll
            for (int mt = 1; mt >= 0; --mt)
#pragma unroll
                for (int g = 3; g >= 0; --g) {
                    const float after = h ? run : run * Go[mt][g];
                    const float p3 = after, p2 = p3 * kp[mt][4 * g + 3], p1 = p2 * kp[mt][4 * g + 2], p0 = p1 * kp[mt][4 * g + 1];
                    sT[mt][4 * g + 3] *= p3;
                    sT[mt][4 * g + 2] *= p2;
                    sT[mt][4 * g + 1] *= p1;
                    sT[mt][4 * g + 0] *= p0;
                    run *= G[mt][g] * Go[mt][g];
                }
            R = run;
        }
#pragma unroll
        for (int mt = 0; mt < 2; ++mt)
#pragma unroll
            for (int s = 0; s < 2; ++s) {
                uint4 pu;
                pu.x = pack2(sT[mt][8 * s], sT[mt][8 * s + 1]); pu.y = pack2(sT[mt][8 * s + 2], sT[mt][8 * s + 3]);
                pu.z = pack2(sT[mt][8 * s + 4], sT[mt][8 * s + 5]); pu.w = pack2(sT[mt][8 * s + 6], sT[mt][8 * s + 7]);
                const bf16x8 pf = __builtin_bit_cast(bf16x8, pu);
#pragma unroll
                for (int dt = 0; dt < NDT; ++dt) {
                    const unsigned char* vp = Vt + (32 * mt + 16 * s + 4 * h + ((lane & 15) >> 2)) * VSTR + dt * 64 + ((lane >> 4) & 1) * 32 + (lane & 3) * 8;
                    const s16x4 a0 = __builtin_amdgcn_ds_read_tr16_b64_v4i16((LAS s16x4*)vp);
                    const s16x4 a1 = __builtin_amdgcn_ds_read_tr16_b64_v4i16((LAS s16x4*)(vp + 8 * VSTR));
                    const bf16x8 av = __builtin_shufflevector(a0, a1, 0, 1, 2, 3, 4, 5, 6, 7);
                    oT[dt] = MFMA32(av, pf, oT[dt]);
                }
            }
    }
    {
        float inv = 1.f;
        if (MODE == 0) { float lt = l_run + __shfl_xor(l_run, 32); inv = __builtin_amdgcn_rcpf(lt); }
        float ss = 0.f;
#pragma unroll
        for (int dt = 0; dt < NDT; ++dt)
#pragma unroll
            for (int i = 0; i < 16; ++i) { oT[dt][i] *= inv; ss += oT[dt][i] * oT[dt][i]; }
        ss += __shfl_xor(ss, 32);
        const float ri = __builtin_amdgcn_rsqf(ss * (1.f / DV) + EPS);
        bf16_t* orow = J.out + (size_t)(32 * wave + r) * J.outs;
        float4 ggv[NDT][4];
#pragma unroll
        for (int dt = 0; dt < NDT; ++dt)
#pragma unroll
            for (int g = 0; g < 4; ++g) ggv[dt][g] = *(const float4*)(J.gain + 32 * dt + 8 * g + 4 * h);
#pragma unroll
        for (int dt = 0; dt < NDT; ++dt)
#pragma unroll
            for (int g = 0; g < 4; ++g) {
                const int d = 32 * dt + 8 * g + 4 * h;
                const float4 gg = ggv[dt][g];
                uint2 b; b.x = pack2(oT[dt][4 * g] * ri * gg.x, oT[dt][4 * g + 1] * ri * gg.y); b.y = pack2(oT[dt][4 * g + 2] * ri * gg.z, oT[dt][4 * g + 3] * ri * gg.w);
                *(uint2*)(orow + d) = b;
            }
    }
    __syncthreads();
}

DI void mixer_job(const Params& P, const int l, const int j, unsigned char* smem) {
    const bf16_t* pb = (const bf16_t*)(P.ws + WS_PROJ);
    bf16_t* mix = (bf16_t*)(P.ws + WS_MIX);
    if (j >= 1920) { gla_stepC(P, l, j - 1920, smem); return; }
    AttnJob J;
    J.q1 = nullptr; J.q1s = 0; J.kn1 = nullptr; J.kn1s = 0; J.kp0 = nullptr; J.kp0s = 0; J.kp1 = nullptr; J.kp1s = 0; J.vp = nullptr; J.vps = 0;
    J.kpf = nullptr; J.vpf = nullptr; J.knf = nullptr; J.vnf = nullptr; J.pfs = 0; J.npast = 0; J.diag = 0; J.NT = 0;
    bool sb; int b, h, qt; bool sample;
    int s_idx = -1, level = 0, w = 0;
    if (j < 1152) { level = j / 72; const int w72 = j - level * 72; if (w72 < 24) s_idx = level * 24 + w72; else w = w72 - 24; }
    else { const int jj = j - 1152; level = 16 + jj / 48; w = jj % 48; }
    if (s_idx >= 0) {
        sample = true; qt = 0;
        if (s_idx < 128) { sb = true; b = s_idx >> 2; h = s_idx & 3; }
        else { const int ss = s_idx - 128; sb = false; b = ss >> 3; h = ss & 7; }
    } else {
        sample = false; qt = 2 * (31 - level);
        if (w < 32) { sb = false; b = w >> 3; h = w & 7; } else { sb = true; b = (w - 32) >> 2; h = (w - 32) & 3; }
    }
    const size_t seq0 = sample ? (size_t)R_P + b * 64 : (size_t)b * 4096;
    const size_t qrow = seq0 + (size_t)qt * 64;
    if (sb) {
        J.q0 = pb + qrow * 2048 + h * 64; J.q0s = 2048;
        J.kn0 = pb + seq0 * 2048 + 256 + h * 64; J.kn0s = 2048;
        J.vn = pb + seq0 * 2048 + 512 + h * 64; J.vns = 2048;
        J.diag = 1;
        J.out = mix + qrow * 1024 + h * 64; J.outs = 1024; J.gain = P.in[15] + l * 64;
        if (sample) {
            J.NT = 65; J.npast = 64;
            J.kpf = P.in[3] + ((((size_t)l * 32 + b) * 4096) * 4 + h) * 64;
            J.vpf = P.in[4] + ((((size_t)l * 32 + b) * 4096) * 4 + h) * 64;
            J.knf = P.out + O_SBK_S + (((size_t)l * 32 + b) * 64) * 256 + h * 64;
            J.vnf = P.out + O_SBV_S + (((size_t)l * 32 + b) * 64) * 256 + h * 64;
            J.pfs = 256;
            attn_job<1, 64, 0, 64, true, SB_PF>(J, smem);
        } else {
            attn_job128<1, 64, 0, 64>(J, qt >> 1, smem);
        }
    } else {
        J.q0 = (const bf16_t*)(P.ws + WS_QN) + qrow * 512 + h * 64; J.q0s = 512;
        J.q1 = (const bf16_t*)(P.ws + WS_QR) + qrow * 256 + h * 32; J.q1s = 256;
        J.kn0 = (const bf16_t*)(P.ws + WS_KNB) + seq0 * 512 + h * 64; J.kn0s = 512;
        J.kn1 = (const bf16_t*)(P.ws + WS_KRB) + seq0 * 32; J.kn1s = 32;
        J.vn = (const bf16_t*)(P.ws + WS_VB) + seq0 * 512 + h * 64; J.vns = 512;
        if (sample) {
            J.NT = 65; J.npast = 64;
            J.kp0 = (const bf16_t*)(P.ws + WS_KNP) + ((size_t)b * 4096) * 512 + h * 64; J.kp0s = 512;
            J.kp1 = (const bf16_t*)(P.ws + WS_KRP) + ((size_t)l * NPAST + (size_t)b * 4096) * 32; J.kp1s = 32;
            J.vp = (const bf16_t*)(P.ws + WS_VP) + ((size_t)b * 4096) * 512 + h * 64; J.vps = 512;
        }
        J.out = mix + qrow * 1024 + 512 + h * 64; J.outs = 1024; J.gain = P.in[24] + l * 64;
        if (sample) attn_job<0, 64, 32, 64, false, true>(J, smem);
        else attn_job128<0, 64, 32, 64>(J, qt >> 1, smem);
    }
}
DI void cross_job(const Params& P, const int l, const int j, unsigned char* smem) {
    AttnJob J;
    J.q1 = nullptr; J.q1s = 0; J.kn1 = nullptr; J.kn1s = 0; J.kp0 = nullptr; J.kp0s = 0; J.kp1 = nullptr; J.kp1s = 0; J.vp = nullptr; J.vps = 0;
    J.kpf = nullptr; J.vpf = nullptr; J.knf = nullptr; J.vnf = nullptr; J.pfs = 0; J.npast = 0; J.diag = 0; J.NT = 4; J.gain = nullptr;
    size_t qrow; int h;
    if (j < 1024) {
        const int qt = j & 63, b = j >> 8; h = (j >> 6) & 3;
        qrow = (size_t)b * 4096 + qt * 64;
        J.kn0 = (const bf16_t*)(P.ws + WS_MEMKP) + ((size_t)l * 1024 + b * 256) * 512 + h * 128;
        J.vn = (const bf16_t*)(P.ws + WS_MEMVP) + ((size_t)l * 1024 + b * 256) * 512 + h * 128;
    } else {
        const int s = j - 1024, b = s >> 2; h = s & 3;
        qrow = (size_t)R_P + b * 64;
        J.kn0 = (const bf16_t*)(P.ws + WS_MEMKS) + (((size_t)l * 32 + b) * 256) * 512 + h * 128;
        J.vn = (const bf16_t*)(P.ws + WS_MEMVS) + (((size_t)l * 32 + b) * 256) * 512 + h * 128;
    }
    J.kn0s = 512; J.vns = 512;
    J.q0 = (const bf16_t*)(P.ws + WS_QC) + qrow * 512 + h * 128; J.q0s = 512;
    J.out = (bf16_t*)(P.ws + WS_OC) + qrow * 512 + h * 128; J.outs = 512;
    attn_job<0, 128, 0, 128, false, CR_PF>(J, smem);
}

#define FOR_DYN(q, total, ci) for (int q = dyn_next((unsigned*)(P.ws + WS_CNT) + (ci)); q < (total); q = dyn_next((unsigned*)(P.ws + WS_CNT) + (ci)))
DI int dyn_next(unsigned* cnt) {
    __shared__ int sjob;
    __syncthreads();
    if (threadIdx.x == 0) sjob = (int)atomicAdd(cnt, 1u);
    __syncthreads();
    return sjob;
}
#define FOR_XJOBS(q, total) for (int it_ = 0, q; (q = ((it_ * 8 + (B & 7)) * (G >> 3)) + (B >> 3)) < (total); ++it_)
DI void run_phase(const Params& P, const int ph, unsigned char* smem, const int rep = 0) {
    const int G = gridDim.x, B = blockIdx.x;
    int tm, tn;
    const bf16_t* W = (const bf16_t*)(P.ws + WS_W);
    if (ph == 0) {
        for (int j = B; j < 18976; j += G) {
            if (j < 6944) prep_weight_tile(P, j, smem);
            else if (j < 11552) prep_x_rows(P, j - 6944);
            else if (j < 11808) prep_mem_rows(P, j - 11552);
            else prep_convert(P, j - 11808);
        }
        return;
    }
    const int l = (ph - 1) / 10, s = (ph - 1) % 10;
    const bf16_t* Wl = W + (size_t)l * W_LAYER;
    if (s == 0) {
        const int extra = (l == 0) ? 128 : 0;
        FOR_XJOBS(j, 2304 + extra) {
            if (j < 2304) { tile_map(j, 16, tm, tn); gemm_tile16<E_PROJ, 2>(P, l, (const bf16_t*)(P.ws + WS_XB), 1024, Wl + W_IN, 1024, tm, tn, smem); }
            else {
                const int jj = j - 2304, ll = jj >> 6, t = jj & 63;
                const bf16_t* Wll = W + (size_t)ll * W_LAYER;
                if (t < 32) gemm_tile<E_MEMK>(P, ll, (const bf16_t*)(P.ws + WS_MEMB), 1024, Wll + W_CK, 1024, t >> 2, t & 3, smem, 0);
                else gemm_tile<E_MEMV>(P, ll, (const bf16_t*)(P.ws + WS_MEMB), 1024, Wll + W_CV, 1024, (t - 32) >> 2, t & 3, smem, 0);
            }
        }
    } else if (s == 1) {
        FOR_XJOBS(j, 1152 + 4608) {
            if (j < 1152) gla_stepA(P, l, j, smem);
            else rowpass(P, l, j - 1152);
        }
        kv_stream(P, l, (const bf16_t*)(P.ws + WS_LATP) + (size_t)l * NPAST * 128, Wl + W_UKV, 0, 8192, smem);
    } else if (s == 2) {
#if REP_MASK & 2048
        FOR_XJOBS(j, 8192) { tile_map(j, 8, tm, tn); gemm_tile<E_KV>(P, l, (const bf16_t*)(P.ws + WS_LATP) + (size_t)l * NPAST * 128, 128, Wl + W_UKV, 128, tm, tn, smem, 1); }
#endif
#if REP_MASK & 4096
        FOR_XJOBS(j, 2016) {
            if (j < 864) { tile_map(j, 6, tm, tn); gemm_tile<E_UQ>(P, l, (const bf16_t*)(P.ws + WS_CQN), 256, Wl + W_UQ, 256, tm, tn, smem, 0); }
            else { tile_map(j - 864, 8, tm, tn); gemm_tile<E_KV>(P, l, (const bf16_t*)(P.ws + WS_LATB), 128, Wl + W_UKV, 128, tm, tn, smem, 0); }
        }
#endif
        FOR_XJOBS(j, 144 + 864 + 1152) {
            if (j < 144) gla_stepB(P, l, j);
            else if (j < 1008) { tile_map(j - 144, 6, tm, tn); gemm_tile<E_UQ>(P, l, (const bf16_t*)(P.ws + WS_CQN), 256, Wl + W_UQ, 256, tm, tn, smem, 0); }
            else { tile_map(j - 1008, 8, tm, tn); gemm_tile<E_KV>(P, l, (const bf16_t*)(P.ws + WS_LATB), 128, Wl + W_UKV, 128, tm, tn, smem, 0); }
        }
    } else if (s == 3) {
        if (P.phase_end - P.phase_begin > 1) {
            FOR_DYN(j, 3072, l + 4 * rep) mixer_job(P, l, j, smem);
        } else {
            for (int j = B; j < 3072; j += G) mixer_job(P, l, j, smem);
        }
    } else if (s == 4) {
        FOR_XJOBS(j, 2304) { tile_map(j, 8, tm, tn); gemm_tile16<E_RES, 1>(P, l, (const bf16_t*)(P.ws + WS_MIX), 1024, Wl + W_OUT, 1024, tm, tn, smem); }
    } else if (s == 5) {
        FOR_XJOBS(j, 1152) { tile_map(j, 4, tm, tn); gemm_tile<E_CQ, 1>(P, l, (const bf16_t*)(P.ws + WS_XB), 1024, Wl + W_CQ, 1024, tm, tn, smem, 0); }
    } else if (s == 6) {
        for (int j = B; j < 1152; j += G) cross_job(P, l, j, smem);
    } else if (s == 7) {
        FOR_XJOBS(j, 2304) { tile_map(j, 8, tm, tn); gemm_tile16<E_RES, 1>(P, l, (const bf16_t*)(P.ws + WS_OC), 512, Wl + W_CO, 512, tm, tn, smem); }
    } else if (s == 8) {
        FOR_XJOBS(j, 6336) { tile_map(j, 44, tm, tn); gemm_tile16<E_GU, 2>(P, l, (const bf16_t*)(P.ws + WS_XB), 1024, Wl + W_GU, 1024, tm, tn, smem); }
    } else {
        FOR_XJOBS(j, 2304) { tile_map(j, 8, tm, tn); gemm_tile16<E_RES, 1>(P, l, (const bf16_t*)(P.ws + WS_ACT), 2816, Wl + W_DN, 2816, tm, tn, smem, l == 1); }
    }
}

__global__ void __launch_bounds__(256, 2) mega_kernel(Params P) {
    extern __shared__ __attribute__((aligned(16))) unsigned char smem[];
    __shared__ uint4 xb_words;
    if (threadIdx.x == 0) xb_words = make_uint4(0u, 0u, 0u, 0u);
    __syncthreads();
    const bool multi = P.phase_end - P.phase_begin > 1;
    XcdBarrier xb;
    if (multi) xb = xcd_barrier_post((unsigned*)(P.ws + WS_BAR), (volatile LAS unsigned*)&xb_words);
    else { xb.bar = nullptr; xb.x = 0; xb.st = (volatile LAS unsigned*)&xb_words; }
    if (P.phase_end < 0) cg::this_grid().sync();
    for (int ph = P.phase_begin; ph < P.phase_end; ++ph) {
        run_phase(P, ph, smem);
#if REP_MASK
        if ((ph > 0 && ((REP_MASK >> ((ph - 1) % 10)) & 1)) || (ph == 0 && (REP_MASK & 1024))) { xcd_barrier(xb); run_phase(P, ph, smem, 1); }
#endif
        if (ph + 1 < P.phase_end) xcd_barrier(xb);
    }
}

extern "C" void kernel_launch(void* const* d_in, const int* in_sizes, int n_in, void* d_out, int out_size, void* d_ws, size_t ws_size,
                              hipStream_t stream) {
    static int grid_blocks = 0;
    if (!grid_blocks) {
        hipFuncSetAttribute((const void*)mega_kernel, hipFuncAttributeMaxDynamicSharedMemorySize, SMEM_BYTES);
        int dev = 0, cus = 0, per_cu = 0;
        hipGetDevice(&dev);
        hipDeviceGetAttribute(&cus, hipDeviceAttributeMultiprocessorCount, dev);
        hipOccupancyMaxActiveBlocksPerMultiprocessor(&per_cu, mega_kernel, 256, SMEM_BYTES);
        if (per_cu < 1) per_cu = 1;
        if (per_cu > 2) per_cu = 2;
        grid_blocks = cus * per_cu;
    }
    if (ws_size < WS_END) { fprintf(stderr, "workspace too small: %zu < %zu\n", ws_size, (size_t)WS_END); return; }
    Params p{};
    for (int i = 0; i < 38; ++i) p.in[i] = (const float*)d_in[i];
    p.out = (float*)d_out;
    p.ws = (unsigned char*)d_ws;
#if ONE_LAUNCH
    p.phase_begin = 0; p.phase_end = NPHASE;
    (void)hipMemsetAsync((unsigned char*)d_ws + WS_BAR, 0, WS_END - WS_BAR, stream);
    void* args[] = {&p};
    hipError_t e = hipLaunchCooperativeKernel((const void*)mega_kernel, dim3(grid_blocks), dim3(256), args, SMEM_BYTES, stream);
    if (e != hipSuccess) fprintf(stderr, "cooperative launch failed: %s (grid %d)\n", hipGetErrorString(e), grid_blocks);
#else
    for (int ph = 0; ph < NPHASE; ++ph) {
        p.phase_begin = ph; p.phase_end = ph + 1;
        hipLaunchKernelGGL(mega_kernel, dim3(grid_blocks), dim3(256), SMEM_BYTES, stream, p);
    }
#endif
}
```
